# Optimizing an MI355X kernel written in HIP

```python
import math
import jax, jax.numpy as jnp
from jax import lax
import numpy as np

D_MODEL = 1024
BATCH = 8
SEQ = 4096
DEPTH = 1

ATT_PATTERNS = ((128, 1), (512, 4), (2048, 16))
ATT_GROUPS = len(ATT_PATTERNS)
ATT_HEADS = 8
ATT_HEAD_DIM = 64
ATT_WIDTH = ATT_HEADS * ATT_HEAD_DIM
ATT_BLOCK = 128
RWKV_WIDTH = D_MODEL
RWKV_HEAD_DIM = 64
RWKV_HEADS = RWKV_WIDTH // RWKV_HEAD_DIM
DECAY_LORA = 64
AAA_LORA = 64
GATE_LORA = 160
D_FF = 2816
CONV_WIDTH = 3
N_BRANCHES = 2
ATT_IN = ATT_GROUPS * 3 * ATT_WIDTH
RWKV_IN = 3 * RWKV_WIDTH + DECAY_LORA + AAA_LORA + GATE_LORA
GATE_IN = N_BRANCHES * D_MODEL
N_IN = ATT_IN + RWKV_IN + GATE_IN
RMS_EPS = 1e-6
GN_EPS = 64e-5

kernel_name = 'hybrid_dilated_attn_rwkv7_convffn_adaln'


def rms_norm(x, w):
    xf = x.astype(jnp.float32)
    y = xf * lax.rsqrt(jnp.mean(xf * xf, axis=-1, keepdims=True) + RMS_EPS)
    return (y * w).astype(x.dtype)


def dilated_window_attention(q, k, v, window, dilation):
    b, s, h, e = q.shape
    back = window // dilation
    sub_len = -(-s // dilation)
    n_blk = -(-sub_len // ATT_BLOCK)
    s_pad = n_blk * ATT_BLOCK * dilation

    def to_blocks(t):
        t = jnp.pad(t, ((0, 0), (0, s_pad - s), (0, 0), (0, 0)))
        return t.reshape(b, n_blk, ATT_BLOCK, dilation, h, e)

    def with_prev(t):
        prev = jnp.concatenate([jnp.zeros_like(t[:, :1]), t[:, :-1]], axis=1)
        return jnp.concatenate([prev, t], axis=2)

    qb = to_blocks(q)
    kc = with_prev(to_blocks(k))
    vc = with_prev(to_blocks(v))
    scores = jnp.einsum('bnqrhe,bnkrhe->bnrhqk', qb, kc).astype(jnp.float32) * (e ** -0.5)
    qi = jnp.arange(ATT_BLOCK)[:, None]
    kj = jnp.arange(2 * ATT_BLOCK)[None, :]
    dist = qi + ATT_BLOCK - kj
    kpos = jnp.arange(n_blk)[:, None] * ATT_BLOCK + kj - ATT_BLOCK
    valid = ((dist >= 0) & (dist <= back))[None] & (kpos >= 0)[:, None, :]
    scores = jnp.where(valid[None, :, None, None], scores, -jnp.inf)
    m = jnp.max(scores, axis=-1, keepdims=True)
    p = jnp.exp(scores - m)
    den = jnp.sum(p, axis=-1)
    num = jnp.einsum('bnrhqk,bnkrhe->bnqrhe', p, vc.astype(jnp.float32))
    den_q = jnp.transpose(den, (0, 1, 4, 2, 3))
    out = (num / den_q[..., None]).reshape(b, s_pad, h, e)[:, :s]
    lse = (jnp.transpose(m[..., 0], (0, 1, 4, 2, 3)) + jnp.log(den_q)).reshape(b, s_pad, h)[:, :s]
    return out, lse


def attention_mixer(z):
    b, s, _ = z.shape
    qkv = z.reshape(b, s, ATT_GROUPS, 3, ATT_HEADS, ATT_HEAD_DIM)
    outs, lses = [], []
    for g, (window, dilation) in enumerate(ATT_PATTERNS):
        o, l = dilated_window_attention(qkv[:, :, g, 0], qkv[:, :, g, 1], qkv[:, :, g, 2], window, dilation)
        outs.append(o)
        lses.append(l)
    wts = jax.nn.softmax(jnp.stack(lses), axis=0)
    out = jnp.sum(wts[..., None] * jnp.stack(outs), axis=0)
    return out.reshape(b, s, ATT_WIDTH).astype(z.dtype)


def rwkv7_mixer(z, mu, w0, w2, a0, a2, g2, k_k, k_a, r_k, lnx_w, lnx_b):
    f32 = jnp.float32
    b, s, _ = z.shape
    z_prev = jnp.pad(z, ((0, 0), (1, 0), (0, 0)))[:, :s]
    z = z + (z_prev - z) * mu
    c = RWKV_WIDTH
    r, k, v, w_low, a_low, g_low = jnp.split(
        z, [c, 2 * c, 3 * c, 3 * c + DECAY_LORA, 3 * c + DECAY_LORA + AAA_LORA], axis=-1)
    w_log = -jax.nn.softplus(-(w0 + jnp.tanh(w_low) @ w2).astype(f32)) - 0.5
    decay = jnp.exp(-jnp.exp(w_log))
    a = jax.nn.sigmoid((a0 + a_low @ a2).astype(f32))
    g = jax.nn.sigmoid(g_low) @ g2
    k_mod = k.astype(f32) * (1.0 + (a - 1.0) * k_a)

    def heads(t):
        return t.astype(f32).reshape(b, s, RWKV_HEADS, RWKV_HEAD_DIM)

    kk = heads(k * k_k)
    kk = kk / jnp.maximum(jnp.sqrt(jnp.sum(kk * kk, axis=-1, keepdims=True)), 1e-12)
    r_h, k_h, v_h, w_h, a_h = heads(r), heads(k_mod), heads(v), heads(decay), heads(a)

    def step(state, inp):
        r_t, w_t, k_t, v_t, aa_t, bb_t = inp
        sa = jnp.einsum('bhvk,bhk->bhv', state, aa_t)
        state = state * w_t[:, :, None, :] + sa[..., None] * bb_t[:, :, None, :] + v_t[..., None] * k_t[:, :, None, :]
        return state, jnp.einsum('bhvk,bhk->bhv', state, r_t)

    tm = lambda t: jnp.swapaxes(t, 0, 1)
    state0 = jnp.zeros((b, RWKV_HEADS, RWKV_HEAD_DIM, RWKV_HEAD_DIM), f32)
    _, y = lax.scan(step, state0, (tm(r_h), tm(w_h), tm(k_h), tm(v_h), tm(-kk), tm(kk * a_h)))
    y = tm(y)
    mean = jnp.mean(y, axis=-1, keepdims=True)
    var = jnp.mean(jnp.square(y - mean), axis=-1, keepdims=True)
    y = ((y - mean) * lax.rsqrt(var + GN_EPS)).reshape(b, s, c) * lnx_w + lnx_b
    bonus = (jnp.sum(r_h * k_h * r_k, axis=-1, keepdims=True) * v_h).reshape(b, s, c)
    return ((y + bonus) * g).astype(z.dtype)


def conv_ffn(h, w_up, conv_w, conv_b, w_down):
    s = h.shape[1]
    u = h @ w_up
    up = jnp.pad(u, ((0, 0), (CONV_WIDTH - 1, 0), (0, 0)))
    u = conv_b + sum(conv_w[j] * up[:, j:j + s] for j in range(CONV_WIDTH))
    gate, val = jnp.split(u, 2, axis=-1)
    return (jax.nn.silu(gate) * val) @ w_down


def setup_inputs(seed: int = 0) -> dict:
    key = jax.random.key(seed)
    ks = iter(jax.random.split(key, 32))
    f32 = jnp.float32
    L, D, C = DEPTH, D_MODEL, RWKV_WIDTH

    def nrm(shape, scale):
        return jax.random.normal(next(ks), shape, f32) * scale

    ramp = (jnp.arange(C, dtype=f32) / (C - 1)) ** 0.85
    inputs = {}
    inputs['x'] = nrm((BATCH, SEQ, D), 1.0)
    inputs['c'] = nrm((BATCH, D), 1.0)
    inputs['w_ada'] = nrm((L, D, 6 * D), 0.3 * D ** -0.5)
    inputs['b_ada'] = nrm((L, 6 * D), 0.02)
    inputs['norm1_w'] = 1.0 + nrm((L, D), 0.05)
    inputs['w_in'] = nrm((L, D, N_IN), D ** -0.5)
    inputs['b_gate'] = nrm((L, GATE_IN), 0.1)
    inputs['mu_shift'] = jax.random.uniform(next(ks), (L, RWKV_IN), f32)
    inputs['w0'] = -6.5 + 5.0 * ramp + nrm((L, C), 0.1)
    inputs['w2'] = nrm((L, DECAY_LORA, C), 0.1 * DECAY_LORA ** -0.5)
    inputs['a0'] = nrm((L, C), 0.1)
    inputs['a2'] = nrm((L, AAA_LORA, C), AAA_LORA ** -0.5)
    inputs['g2'] = nrm((L, GATE_LORA, C), GATE_LORA ** -0.5)
    inputs['k_k'] = 0.85 + nrm((L, C), 0.05)
    inputs['k_a'] = 1.0 + nrm((L, C), 0.05)
    inputs['r_k'] = nrm((L, RWKV_HEADS, RWKV_HEAD_DIM), 0.1)
    inputs['lnx_w'] = 1.0 + nrm((L, C), 0.05)
    inputs['lnx_b'] = nrm((L, C), 0.02)
    inputs['w_att_out'] = nrm((L, ATT_WIDTH, D), ATT_WIDTH ** -0.5)
    inputs['w_rwkv_out'] = nrm((L, C, D), C ** -0.5)
    inputs['w_o'] = nrm((L, D, D), D ** -0.5)
    inputs['norm2_w'] = 1.0 + nrm((L, D), 0.05)
    inputs['w_up'] = nrm((L, D, 2 * D_FF), D ** -0.5)
    inputs['conv_w'] = nrm((L, CONV_WIDTH, 2 * D_FF), CONV_WIDTH ** -0.5)
    inputs['conv_b'] = nrm((L, 2 * D_FF), 0.02)
    inputs['w_down'] = nrm((L, D_FF, D), D_FF ** -0.5)
    inputs['norm_f_w'] = 1.0 + nrm((D,), 0.05)
    return inputs


def reference(x, c, w_ada, b_ada, norm1_w, w_in, b_gate, mu_shift, w0, w2, a0, a2, g2, k_k, k_a, r_k,
              lnx_w, lnx_b, w_att_out, w_rwkv_out, w_o, norm2_w, w_up, conv_w, conv_b, w_down, norm_f_w):
    for l in range(DEPTH):
        ada = (c @ w_ada[l] + b_ada[l])[:, None, :]
        sh1, sc1, gt1, sh2, sc2, gt2 = jnp.split(ada, 6, axis=-1)
        h = rms_norm(x, norm1_w[l]) * (1.0 + sc1) + sh1
        proj = h @ w_in[l]
        att_in, rwkv_in, gate_in = jnp.split(proj, [ATT_IN, ATT_IN + RWKV_IN], axis=-1)
        y_att = attention_mixer(att_in) @ w_att_out[l]
        y_rwkv = rwkv7_mixer(rwkv_in, mu_shift[l], w0[l], w2[l], a0[l], a2[l], g2[l], k_k[l], k_a[l],
                             r_k[l], lnx_w[l], lnx_b[l]) @ w_rwkv_out[l]
        g_att, g_rwkv = jnp.split(jax.nn.sigmoid(gate_in + b_gate[l]), N_BRANCHES, axis=-1)
        x = x + gt1 * ((g_att * y_att + g_rwkv * y_rwkv) @ w_o[l])
        h = rms_norm(x, norm2_w[l]) * (1.0 + sc2) + sh2
        x = x + gt2 * conv_ffn(h, w_up[l], conv_w[l], conv_b[l], w_down[l])
    return rms_norm(x, norm_f_w)
```

```cpp
#include <hip/hip_runtime.h>
#include <hip/hip_cooperative_groups.h>
#include <cstdio>
#include <cstdint>
namespace cg = cooperative_groups;

#ifndef MK_ONE_LAUNCH
#define MK_ONE_LAUNCH 1
#endif

#define LAS __attribute__((address_space(3)))
typedef unsigned short bf16_t;
typedef short bf16x8 __attribute__((ext_vector_type(8)));
typedef float f32x4 __attribute__((ext_vector_type(4)));
typedef float f32x2 __attribute__((ext_vector_type(2)));
typedef unsigned u32x4 __attribute__((ext_vector_type(4)));
typedef unsigned u32x2 __attribute__((ext_vector_type(2)));
typedef LAS unsigned char* lds_t;

constexpr int SEQ = 4096, NB = 8, D = 1024, MTOK = NB * SEQ;
constexpr int NRW = 3584;
constexpr int NAG = 6656;
constexpr int DFF = 2816;
constexpr int CH = 16384;
constexpr int NTHREADS = 512;
constexpr int LDS_BYTES = 131072 + 16;
constexpr int N_PHASES = 8 + (4 + 3) + 2 + (MK_ONE_LAUNCH ? 5 : 6);

constexpr size_t MiB = 1048576;
constexpr size_t WS_WATTO = 0 * MiB, WS_WRWO = 1 * MiB, WS_WO = 3 * MiB, WS_WLORA = 5 * MiB, WS_ADA = 7 * MiB + 512 * 1024;
constexpr size_t WS_WINRW = 8 * MiB, WS_WINAG = 15 * MiB;
constexpr size_t WS_H1 = 45 * MiB, WS_Y = 45 * MiB, WS_PRW = 109 * MiB, WS_ALORA = 333 * MiB, WS_EA = 357 * MiB, WS_BS = 485 * MiB;
constexpr size_t WS_G = 357 * MiB, WS_RWO = 421 * MiB;
constexpr size_t WS_H1C = 28 * MiB, WS_PATT = 60 * MiB, WS_ATTO = 204 * MiB, WS_LSE = 8 * MiB, WS_PGATE = 252 * MiB, WS_ATTM = 380 * MiB;
constexpr size_t WS_T1 = 28 * MiB, WS_MIX = 156 * MiB;
constexpr size_t WS_WUP = 8 * MiB, WS_WDN = 19 * MiB, WS_H2 = 28 * MiB, WS_U = 92 * MiB, WS_HALO = 444 * MiB;
constexpr size_t WS_BAR = 503 * MiB;
constexpr size_t WS_NEED = 504 * MiB;

__device__ __forceinline__ float bf_lo(unsigned u) { return __uint_as_float(u << 16); }
__device__ __forceinline__ float bf_hi(unsigned u) { return __uint_as_float(u & 0xffff0000u); }
__device__ __forceinline__ float bf2f(bf16_t v) { return __uint_as_float(((unsigned)v) << 16); }
__device__ __forceinline__ unsigned pk_bf16(float lo, float hi) { unsigned r; asm volatile("v_cvt_pk_bf16_f32 %0, %1, %2" : "=v"(r) : "v"(lo), "v"(hi)); return r; }
__device__ __forceinline__ bf16_t f2bf(float f) { return (bf16_t)(pk_bf16(f, 0.f) & 0xffffu); }
__device__ __forceinline__ int lane_id_asm() { int l; asm volatile("v_mbcnt_lo_u32_b32 %0, -1, 0\n\tv_mbcnt_hi_u32_b32 %0, -1, %0" : "=v"(l)); return l; }
__device__ __forceinline__ int ltid_w(int w) { asm volatile("" : "+s"(w)); return w * 64 + lane_id_asm(); }
#define ltid() ltid_w(WV)
__device__ __forceinline__ float sigm(float x) { return __builtin_amdgcn_rcpf(1.0f + __expf(-x)); }
template <int CTRL> __device__ __forceinline__ float dppf(float x) { return __builtin_bit_cast(float, __builtin_amdgcn_mov_dpp(__builtin_bit_cast(int, x), CTRL, 0xf, 0xf, true)); }
__device__ __forceinline__ float allred16(float x) { x += dppf<0xB1>(x); x += dppf<0x4E>(x); x += dppf<0x141>(x); x += dppf<0x128>(x); return x; }

namespace pg8 {
constexpr int BM = 256, BK = 64, HALF = 128, HTB = HALF * BK * 2, STAGE_BYTES = 8 * HTB, NXCD = 8, WGM = 8;
__host__ __device__ __forceinline__ int lds_byte(int r, int c) { const int st = (r >> 4) * 2 + (c >> 5), rr = r & 15, cc = c & 31, ob = rr * 64 + cc * 2; return st * 1024 + (ob ^ (((ob >> 9) & 1) << 5)); }
__host__ __device__ __forceinline__ void stage_rc(int b, int& R, int& C) { const int st = b / 1024, sb = b % 1024, swz = sb ^ (((sb >> 9) & 1) << 5); R = (st >> 1) * 16 + swz / 64; C = (st & 1) * 32 + (swz % 64) / 2; }
__host__ __device__ __forceinline__ int perm32(int rho) { const int n = rho >> 4, i = rho & 15; return 8 * (i >> 2) + 4 * n + (i & 3); }
struct Unit { int pm, pn; };
struct Gemm { const bf16_t* A; const bf16_t* Bt; int M, N, K, lda, ldb; };
struct StaticOrder {
    int nM, nN, nwg, G, c;
    __device__ void init(int M, int N, int G_, int c_) { nM = M / BM; nN = N / BM; nwg = nM * nN; G = G_; c = c_; }
    __device__ bool next(int i, Unit& u) const {
        const long L = (long)i * G + c; if (L >= nwg) return false;
        int wgid = (int)L; { const int q = nwg / NXCD, r = nwg % NXCD, xcd = wgid % NXCD, off = wgid / NXCD; wgid = (xcd < r ? xcd * (q + 1) : r * (q + 1) + (xcd - r) * q) + off; }
        const int nig = WGM * nN, gid = wgid / nig, fm = gid * WGM, gsz = (nM - fm) < WGM ? (nM - fm) : WGM;
        u.pm = fm + ((wgid % nig) % gsz); u.pn = (wgid % nig) / gsz; return true;
    }
};

template <class Epi, bool ALIGN_EPI = true>
__device__ __forceinline__ void gemm_phase(const int WV, lds_t lds, const Gemm g, const StaticOrder& S, const Epi& E) {
    const int tid = ltid(), wid = __builtin_amdgcn_readfirstlane(tid >> 6), lane = tid & 63, wr = wid >> 2, wc = wid & 3, fr = lane & 15, fq = lane >> 4;
    const int K = g.K, nt = K / BK;
    unsigned voffA[2], voffB[2];
#pragma unroll
    for (int i = 0; i < 2; ++i) { int R, C; stage_rc(tid * 16 + i * 8192, R, C); const int Rb = Epi::PERM ? ((R & ~31) + perm32(R & 31)) : R;
        voffA[i] = (unsigned)(R * g.lda + C) * 2u; voffB[i] = (unsigned)(Rb * g.ldb + C) * 2u; }
    const size_t kstep = (size_t)(BK * 2);
    const size_t hstepA = (size_t)HALF * g.lda * 2, hstepB = (size_t)HALF * g.ldb * 2;
    const size_t tstepA = 2 * hstepA, tstepB = 2 * hstepB;
    const unsigned ldsw = (unsigned)wid * 1024u;
    const int aoff = lds_byte(wr * 64 + fr, fq * 8), boff = lds_byte(wc * 32 + fr, fq * 8);
#define PG8_SA(b, h) (((b) * 2 + (h)) * HTB)
#define PG8_SB(b, h) ((4 + (b) * 2 + (h)) * HTB)
#define PG8_STAGE(bufoff, gbase, voff) do { _Pragma("unroll") for (int _i = 0; _i < 2; ++_i) \
        __builtin_amdgcn_global_load_lds((const unsigned*)((const char*)(gbase) + (voff)[_i]), (LAS unsigned*)(lds + (bufoff) + ldsw + _i * 8192), 16, 0, 0); } while (0)
#define PG8_LDA(dst, b, h) do { _Pragma("unroll") for (int m = 0; m < 4; ++m) _Pragma("unroll") for (int k = 0; k < 2; ++k) dst[m][k] = *(const LAS bf16x8*)(lds + PG8_SA(b, h) + aoff + m * 2048 + k * 1024); } while (0)
#define PG8_LDB(dst, b, h) do { _Pragma("unroll") for (int n = 0; n < 2; ++n) _Pragma("unroll") for (int k = 0; k < 2; ++k) dst[n][k] = *(const LAS bf16x8*)(lds + PG8_SB(b, h) + boff + n * 2048 + k * 1024); } while (0)
#define PG8_MMA(ai, bj, At, Bt) do { __builtin_amdgcn_s_setprio(1); _Pragma("unroll") for (int m = 0; m < 4; ++m) _Pragma("unroll") for (int n = 0; n < 2; ++n) _Pragma("unroll") for (int k = 0; k < 2; ++k) \
        acc[ai][bj][m][n] = __builtin_amdgcn_mfma_f32_16x16x32_bf16(Bt[n][k], At[m][k], acc[ai][bj][m][n], 0, 0, 0); __builtin_amdgcn_s_setprio(0); } while (0)
#define PG8_WAIT_V(n) asm volatile("s_waitcnt vmcnt(" #n ")" ::: "memory")
#define PG8_WAIT_L(n) asm volatile("s_waitcnt lgkmcnt(" #n ")" ::: "memory")
#define PG8_BAR __builtin_amdgcn_s_barrier()
#define PG8_SCHED __builtin_amdgcn_sched_barrier(0)
    Unit cur, nxt; int ui = 0;
    if (!S.next(0, cur)) return;
    f32x4 acc[2][2][4][2];
#pragma unroll
    for (int a = 0; a < 2; ++a)
#pragma unroll
        for (int b = 0; b < 2; ++b)
#pragma unroll
            for (int m = 0; m < 4; ++m)
#pragma unroll
                for (int n = 0; n < 2; ++n) acc[a][b][m][n] = (f32x4){0.f, 0.f, 0.f, 0.f};
    bf16x8 At[4][2], B0[2][2], B1[2][2];
    const char* cA = (const char*)g.A + (size_t)cur.pm * tstepA; const char* cB = (const char*)g.Bt + (size_t)cur.pn * tstepB;
    PG8_STAGE(PG8_SB(0, 0), cB, voffB); PG8_STAGE(PG8_SB(0, 1), cB + hstepB, voffB); PG8_STAGE(PG8_SA(0, 0), cA, voffA); PG8_STAGE(PG8_SA(0, 1), cA + hstepA, voffA);
    if (wr == 1) PG8_BAR;
    PG8_WAIT_V(2); PG8_BAR;
    PG8_STAGE(PG8_SB(1, 0), cB + kstep, voffB); PG8_STAGE(PG8_SA(1, 0), cA + kstep, voffA); PG8_STAGE(PG8_SB(1, 1), cB + hstepB + kstep, voffB);
    PG8_WAIT_V(6); PG8_BAR;
    for (;;) {
        const bool has_next = S.next(ui + 1, nxt);
        const char* nA = has_next ? (const char*)g.A + (size_t)nxt.pm * tstepA : cA; const char* nB = has_next ? (const char*)g.Bt + (size_t)nxt.pn * tstepB : cB;
        for (int t = 0; t < nt; t += 2) {
            const bool last = (t == nt - 2);
            const char* a1 = cA + (size_t)(t + 1) * kstep;
            const char* a2 = last ? nA : cA + (size_t)(t + 2) * kstep; const char* b2 = last ? nB : cB + (size_t)(t + 2) * kstep;
            const char* a3 = a2 + kstep; const char* b3 = b2 + kstep;
            PG8_LDB(B0, 0, 0); PG8_LDB(B1, 0, 1); PG8_SCHED; PG8_LDA(At, 0, 0); PG8_STAGE(PG8_SA(1, 1), a1 + hstepA, voffA);
            PG8_WAIT_V(8); PG8_WAIT_L(0); PG8_BAR; PG8_MMA(0, 0, At, B0); PG8_MMA(0, 1, At, B1); PG8_BAR; PG8_SCHED;
            PG8_LDA(At, 0, 1); PG8_STAGE(PG8_SB(0, 0), b2, voffB); PG8_STAGE(PG8_SB(0, 1), b2 + hstepB, voffB); PG8_STAGE(PG8_SA(0, 0), a2, voffA);
            PG8_WAIT_V(8); PG8_WAIT_L(0); PG8_BAR; PG8_MMA(1, 0, At, B0); PG8_MMA(1, 1, At, B1); PG8_BAR; PG8_SCHED;
            PG8_LDB(B0, 1, 0); PG8_LDB(B1, 1, 1); PG8_SCHED; PG8_LDA(At, 1, 0); PG8_STAGE(PG8_SA(0, 1), a2 + hstepA, voffA);
            PG8_WAIT_V(8); PG8_WAIT_L(0); PG8_BAR; PG8_MMA(0, 0, At, B0); PG8_MMA(0, 1, At, B1); PG8_BAR; PG8_SCHED;
            PG8_LDA(At, 1, 1); PG8_STAGE(PG8_SB(1, 0), b3, voffB); PG8_STAGE(PG8_SB(1, 1), b3 + hstepB, voffB); PG8_STAGE(PG8_SA(1, 0), a3, voffA);
            PG8_WAIT_V(8); PG8_WAIT_L(0); PG8_BAR; PG8_MMA(1, 0, At, B0); PG8_MMA(1, 1, At, B1); PG8_BAR; PG8_SCHED;
        }
        if constexpr (ALIGN_EPI) { if (wr == 0) PG8_BAR; }
        E(acc, cur, wr, wc, fr, fq);
        if (!has_next) break;
#pragma unroll
        for (int a = 0; a < 2; ++a)
#pragma unroll
            for (int b = 0; b < 2; ++b)
#pragma unroll
                for (int m = 0; m < 4; ++m)
#pragma unroll
                    for (int n = 0; n < 2; ++n) acc[a][b][m][n] = (f32x4){0.f, 0.f, 0.f, 0.f};
        cur = nxt; cA = nA; cB = nB; ++ui;
        if constexpr (ALIGN_EPI) { if (wr == 1) PG8_BAR; }
    }
    PG8_WAIT_V(0);
    if constexpr (!ALIGN_EPI) { if (wr == 0) PG8_BAR; }
    PG8_BAR;
#undef PG8_SA
#undef PG8_SB
#undef PG8_STAGE
#undef PG8_LDA
#undef PG8_LDB
#undef PG8_MMA
#undef PG8_WAIT_V
#undef PG8_WAIT_L
#undef PG8_BAR
#undef PG8_SCHED
}

enum { EP_BF16 = 0, EP_EA = 1, EP_ATTOUT = 2, EP_RWOUT = 3, EP_RESID = 4, EP_EAH = 5 };
struct EpiArgs {
    bf16_t* o0; bf16_t* o1; int ld0, ld1, ncol0, row0g;
    const float* p0; const float* p1;
    const bf16_t* gate; float* t1; const float* base; float* outf;
};
template <int MODE> struct Epi {
    static constexpr bool PERM = (MODE == EP_BF16 || MODE == EP_EA || MODE == EP_RWOUT || MODE == EP_EAH);
    EpiArgs a;
    __device__ __forceinline__ void operator()(const f32x4 (&acc)[2][2][4][2], const Unit& u, int wr, int wc, int fr, int fq) const {
        { const int l_ = lane_id_asm(); fr = l_ & 15; fq = l_ >> 4; }
        const int row0 = u.pm * BM + wr * 64 + fr;
        if constexpr (MODE == EP_BF16) {
            int colt = u.pn * BM; bf16_t* base = a.o0; int ld = a.ld0;
            if (colt >= a.ncol0) { base = a.o1; ld = a.ld1; colt -= a.ncol0; }
            const int col0 = colt + wc * 32 + 8 * fq;
#pragma unroll
            for (int ai = 0; ai < 2; ++ai)
#pragma unroll
                for (int m = 0; m < 4; ++m) { bf16_t* rowp = base + (size_t)(row0 + ai * HALF + m * 16) * ld + col0;
#pragma unroll
                    for (int bj = 0; bj < 2; ++bj) { const f32x4 v0 = acc[ai][bj][m][0], v1 = acc[ai][bj][m][1];
                        u32x4 w; w.x = pk_bf16(v0[0], v0[1]); w.y = pk_bf16(v0[2], v0[3]); w.z = pk_bf16(v1[0], v1[1]); w.w = pk_bf16(v1[2], v1[3]);
                        *(u32x4*)(rowp + bj * HALF) = w; }
                    asm volatile("" ::: "memory"); }
        } else if constexpr (MODE == EP_EAH) {
            const int frl = fr, fql = fq;
            const int rb = u.pm * BM, bb = rb >> 12, t0 = (rb & 4095) + wr * 64 + frl;
            const int c0 = u.pn * BM + wc * 32 + 8 * fql, c1 = c0 + HALF;
            const unsigned of0 = (unsigned)(bb * 16 + ((c0 >> 6) & 15)) * 524288u + (unsigned)t0 * 128u + (unsigned)((c0 >> 10) * 64 + (c0 & 63));
            const unsigned of1 = (unsigned)(bb * 16 + ((c1 >> 6) & 15)) * 524288u + (unsigned)t0 * 128u + (unsigned)((c1 >> 10) * 64 + (c1 & 63));
#pragma unroll
            for (int ai = 0; ai < 2; ++ai)
#pragma unroll
                for (int m = 0; m < 4; ++m) {
#pragma unroll
                    for (int bj = 0; bj < 2; ++bj) { const f32x4 v0 = acc[ai][bj][m][0], v1 = acc[ai][bj][m][1];
                        u32x4 w; w.x = pk_bf16(v0[0], v0[1]); w.y = pk_bf16(v0[2], v0[3]); w.z = pk_bf16(v1[0], v1[1]); w.w = pk_bf16(v1[2], v1[3]);
                        *(u32x4*)(a.o0 + ((bj ? of1 : of0) + (unsigned)((ai * HALF + m * 16) * 128))) = w; }
                    asm volatile("" ::: "memory"); }
        } else if constexpr (MODE == EP_EA) {
            const int col0 = u.pn * BM + wc * 32 + 8 * fq;
            const bool isw = (u.pn < 4);
            const float* bias = isw ? a.p0 : (a.p1 - 1024);
            const float scl = isw ? 0.60653066f : 1.0f;
#pragma unroll
            for (int ai = 0; ai < 2; ++ai)
#pragma unroll
                for (int m = 0; m < 4; ++m) { bf16_t* rowp = a.o0 + (size_t)(row0 + ai * HALF + m * 16) * a.ld0 + col0;
#pragma unroll
                    for (int bj = 0; bj < 2; ++bj) { const f32x4 bv0 = *(const f32x4*)(bias + col0 + bj * HALF), bv1 = *(const f32x4*)(bias + col0 + bj * HALF + 4);
                        f32x4 v0 = acc[ai][bj][m][0] + bv0, v1 = acc[ai][bj][m][1] + bv1;
#pragma unroll
                        for (int j = 0; j < 4; ++j) { v0[j] = scl * sigm(v0[j]); v1[j] = scl * sigm(v1[j]); }
                        u32x4 w; w.x = pk_bf16(v0[0], v0[1]); w.y = pk_bf16(v0[2], v0[3]); w.z = pk_bf16(v1[0], v1[1]); w.w = pk_bf16(v1[2], v1[3]);
                        *(u32x4*)(rowp + bj * HALF) = w; }
                    asm volatile("" ::: "memory"); }
        } else if constexpr (MODE == EP_ATTOUT) {
            const int col0 = u.pn * BM + wc * 32 + 4 * fq;
#pragma unroll
            for (int ai = 0; ai < 2; ++ai)
#pragma unroll
                for (int m = 0; m < 4; ++m) { const size_t r = (size_t)(row0 + ai * HALF + m * 16);
#pragma unroll
                    for (int bj = 0; bj < 2; ++bj)
#pragma unroll
                        for (int n = 0; n < 2; ++n) { const int c = col0 + bj * HALF + n * 16;
                            const u32x2 gq = *(const u32x2*)(a.gate + r * 2048 + c); const f32x4 bg = *(const f32x4*)(a.p0 + c);
                            const f32x4 v = acc[ai][bj][m][n]; f32x4 o;
                            o[0] = sigm(bf_lo(gq.x) + bg[0]) * v[0]; o[1] = sigm(bf_hi(gq.x) + bg[1]) * v[1]; o[2] = sigm(bf_lo(gq.y) + bg[2]) * v[2]; o[3] = sigm(bf_hi(gq.y) + bg[3]) * v[3];
                            *(f32x4*)(a.t1 + r * 1024 + c) = o; }
                    asm volatile("" ::: "memory"); }
        } else if constexpr (MODE == EP_RWOUT) {
            const int col0 = u.pn * BM + wc * 32 + 8 * fq;
#pragma unroll
            for (int ai = 0; ai < 2; ++ai)
#pragma unroll
                for (int m = 0; m < 4; ++m) { const size_t r = (size_t)(row0 + ai * HALF + m * 16);
#pragma unroll
                    for (int bj = 0; bj < 2; ++bj) { const int c = col0 + bj * HALF;
                        const u32x4 gq = *(const u32x4*)(a.gate + r * 2048 + 1024 + c);
                        const f32x4 b0 = *(const f32x4*)(a.p0 + 1024 + c), b1 = *(const f32x4*)(a.p0 + 1024 + c + 4);
                        const f32x4 t0 = *(const f32x4*)(a.t1 + r * 1024 + c), t1v = *(const f32x4*)(a.t1 + r * 1024 + c + 4);
                        const f32x4 v0 = acc[ai][bj][m][0], v1 = acc[ai][bj][m][1]; f32x4 o0, o1;
                        o0[0] = t0[0] + sigm(bf_lo(gq.x) + b0[0]) * v0[0]; o0[1] = t0[1] + sigm(bf_hi(gq.x) + b0[1]) * v0[1];
                        o0[2] = t0[2] + sigm(bf_lo(gq.y) + b0[2]) * v0[2]; o0[3] = t0[3] + sigm(bf_hi(gq.y) + b0[3]) * v0[3];
                        o1[0] = t1v[0] + sigm(bf_lo(gq.z) + b1[0]) * v1[0]; o1[1] = t1v[1] + sigm(bf_hi(gq.z) + b1[1]) * v1[1];
                        o1[2] = t1v[2] + sigm(bf_lo(gq.w) + b1[2]) * v1[2]; o1[3] = t1v[3] + sigm(bf_hi(gq.w) + b1[3]) * v1[3];
                        u32x4 w; w.x = pk_bf16(o0[0], o0[1]); w.y = pk_bf16(o0[2], o0[3]); w.z = pk_bf16(o1[0], o1[1]); w.w = pk_bf16(o1[2], o1[3]);
                        *(u32x4*)(a.o0 + r * 1024 + c) = w; }
                    asm volatile("" ::: "memory"); }
        } else {
            const int col0 = u.pn * BM + wc * 32 + 4 * fq;
            const int bidx = (a.row0g + u.pm * BM) >> 12;
            const float* gp = a.p0 + (size_t)bidx * 6144 + col0;
#pragma unroll
            for (int ai = 0; ai < 2; ++ai)
#pragma unroll
                for (int m = 0; m < 4; ++m) { const size_t off = (size_t)(row0 + ai * HALF + m * 16) * 1024 + col0;
#pragma unroll
                    for (int bj = 0; bj < 2; ++bj)
#pragma unroll
                        for (int n = 0; n < 2; ++n) { const f32x4 bs = *(const f32x4*)(a.base + off + bj * HALF + n * 16); const f32x4 gv = *(const f32x4*)(gp + bj * HALF + n * 16);
                            *(f32x4*)(a.outf + off + bj * HALF + n * 16) = bs + gv * acc[ai][bj][m][n]; }
                    asm volatile("" ::: "memory"); }
        }
    }
};
}

#define XB_TMO      128
#define XB_XCNT(j)  (256  + 64 * (j))
#define XB_XSUB(j)  (1280 + 64 * (j))
#define XB_XGEN(j)  (2304 + 64 * (j))
#define XB_TOP      3328
#define XB_TOPGEN   3392
#define XCD_BAR_WORDS 3456
#define XB_SPIN_CAP (1u << 20)
__device__ __forceinline__ unsigned xb_ld(unsigned* p)              { return __hip_atomic_load(p, __ATOMIC_RELAXED, __HIP_MEMORY_SCOPE_AGENT); }
__device__ __forceinline__ unsigned xb_add(unsigned* p, unsigned v) { return __hip_atomic_fetch_add(p, v, __ATOMIC_RELAXED, __HIP_MEMORY_SCOPE_AGENT); }
__device__ __forceinline__ unsigned xb_xcc_id() { return (unsigned)__builtin_amdgcn_s_getreg((3 << 11) | 20) & 0xFu; }
#define XB_SPIN(cond, bar) do { unsigned _sp = 0; while (cond) { __builtin_amdgcn_s_sleep(1); \
    if ((++_sp & 255u) == 0u) { if (xb_ld(&(bar)[XB_TMO])) break; if (_sp > XB_SPIN_CAP) { atomicAdd(&(bar)[XB_TMO], 1u); break; } } } } while (0)
__device__ __forceinline__ void xcd_barrier_complete(unsigned* bar, unsigned x, unsigned& nloc, unsigned& nx) {
    const unsigned G = gridDim.x; unsigned sum, cnt, mine, sp = 0u;
    for (;;) {
        sum = 0u; cnt = 0u; mine = 0u;
#pragma unroll
        for (unsigned j = 0; j < 16; ++j) { const unsigned c = xb_ld(&bar[XB_XCNT(j)]); sum += c; cnt += (c > 0u) ? 1u : 0u; mine = (j == x) ? c : mine; }
        if (sum == G) break;
        __builtin_amdgcn_s_sleep(1);
        if ((++sp & 255u) == 0u) { if (xb_ld(&bar[XB_TMO])) break; if (sp > XB_SPIN_CAP) { atomicAdd(&bar[XB_TMO], 1u); break; } }
    }
    nloc = mine > 0u ? mine : 1u; nx = cnt > 0u ? cnt : 1u;
}
__device__ __forceinline__ void xcd_barrier(const int WV, unsigned* bar, volatile LAS unsigned* st) {
    asm volatile("s_waitcnt vmcnt(0)" ::: "memory");
    __syncthreads();
    if (ltid() == 0) {
        const unsigned x = xb_xcc_id();
        __builtin_amdgcn_s_waitcnt(0);
        unsigned nloc = st[0], nx = st[1];
        if (nloc == 0u) { xcd_barrier_complete(bar, x, nloc, nx); st[0] = nloc; st[1] = nx; }
        const unsigned old = xb_add(&bar[XB_XSUB(x)], 1u);
        const unsigned gen = old / nloc;
        if (old + 1u == (gen + 1u) * nloc) {
            __builtin_amdgcn_fence(__ATOMIC_RELEASE, "agent");
            asm volatile("s_waitcnt vmcnt(0)" ::: "memory");
            const unsigned og = xb_add(&bar[XB_TOP], 1u);
            const unsigned tg = og / nx;
            if (og + 1u == (tg + 1u) * nx) xb_add(&bar[XB_TOPGEN], 1u);
            else XB_SPIN(xb_ld(&bar[XB_TOPGEN]) == tg, bar);
            __builtin_amdgcn_fence(__ATOMIC_ACQUIRE, "agent");
            xb_add(&bar[XB_XGEN(x)], 1u);
            asm volatile("s_waitcnt vmcnt(0)" ::: "memory");
        } else {
            XB_SPIN(xb_ld(&bar[XB_XGEN(x)]) == gen, bar);
            __builtin_amdgcn_fence(__ATOMIC_ACQUIRE, "agent");
            asm volatile("s_waitcnt vmcnt(0)" ::: "memory");
        }
    }
    __syncthreads();
}

struct Args { const float* in[27]; float* out; unsigned char* ws; int ph_lo, ph_hi; };
typedef const __attribute__((address_space(4))) Args* kargs_t;
__device__ __forceinline__ kargs_t launder_args(kargs_t p) { asm volatile("" : "+s"(p)); return p; }
enum { I_X = 0, I_C, I_WADA, I_BADA, I_N1W, I_WIN, I_BGATE, I_MU, I_W0, I_W2, I_A0, I_A2, I_G2, I_KK, I_KA, I_RK, I_LNW, I_LNB, I_WATTO, I_WRWO, I_WO, I_N2W, I_WUP, I_CONVW, I_CONVB, I_WDN, I_NFW };

__device__ __forceinline__ void conv_job(const int WV, const float* src, int ldn, int c0, int K, bf16_t* dst, int ldk, int r0, int nrows, lds_t lds) {
    LAS float* tile = (LAS float*)lds;
    const int tid = ltid(), nkt = K / 64, ntiles = (nrows / 32) * nkt;
    const int kl = tid >> 3, n4 = (tid & 7) * 4, nl = tid >> 4, k4 = (tid & 15) * 4;
    int t = blockIdx.x; f32x4 vn = (f32x4){0.f, 0.f, 0.f, 0.f};
    if (t < ntiles) vn = *(const f32x4*)(src + (size_t)((t % nkt) * 64 + kl) * ldn + c0 + (t / nkt) * 32 + n4);
    for (; t < ntiles; t += gridDim.x) {
        const int n0 = (t / nkt) * 32, k0 = (t % nkt) * 64; const f32x4 v = vn;
        const int tn = t + gridDim.x;
        if (tn < ntiles) vn = *(const f32x4*)(src + (size_t)((tn % nkt) * 64 + kl) * ldn + c0 + (tn / nkt) * 32 + n4);
        tile[kl * 33 + n4 + 0] = v[0]; tile[kl * 33 + n4 + 1] = v[1]; tile[kl * 33 + n4 + 2] = v[2]; tile[kl * 33 + n4 + 3] = v[3];
        __syncthreads();
        { u32x2 w; w.x = pk_bf16(tile[(k4 + 0) * 33 + nl], tile[(k4 + 1) * 33 + nl]); w.y = pk_bf16(tile[(k4 + 2) * 33 + nl], tile[(k4 + 3) * 33 + nl]);
          *(u32x2*)(dst + (size_t)(r0 + n0 + nl) * ldk + k0 + k4) = w; }
        __syncthreads();
    }
}
__device__ __forceinline__ void p0_weights(const int WV, kargs_t A, lds_t lds) {
    unsigned char* ws = A->ws; const int tid = ltid(), G = gridDim.x; const size_t gtid = (size_t)blockIdx.x * NTHREADS + tid, gsz = (size_t)G * NTHREADS;
    conv_job(WV, A->in[I_WIN], 10016, 4608, 1024, (bf16_t*)(ws + WS_WINRW), 1024, 0, 3360, lds);
    conv_job(WV, A->in[I_WIN], 10016, 0, 1024, (bf16_t*)(ws + WS_WINAG), 1024, 0, 4608, lds);
    conv_job(WV, A->in[I_WIN], 10016, 7968, 1024, (bf16_t*)(ws + WS_WINAG), 1024, 4608, 2048, lds);
    conv_job(WV, A->in[I_WATTO], 1024, 0, 512, (bf16_t*)(ws + WS_WATTO), 512, 0, 1024, lds);
    conv_job(WV, A->in[I_WRWO], 1024, 0, 1024, (bf16_t*)(ws + WS_WRWO), 1024, 0, 1024, lds);
    conv_job(WV, A->in[I_WO], 1024, 0, 1024, (bf16_t*)(ws + WS_WO), 1024, 0, 1024, lds);
    { unsigned* z = (unsigned*)(ws + WS_WINRW + (size_t)3360 * 1024 * 2); for (size_t i = gtid; i < (size_t)224 * 512; i += gsz) z[i] = 0u; }
    { bf16_t* wl = (bf16_t*)(ws + WS_WLORA); const float* w2 = A->in[I_W2]; const float* a2 = A->in[I_A2]; const float* g2 = A->in[I_G2];
      for (size_t i = gtid; i < (size_t)384 * 3072; i += gsz) { const int k = (int)(i / 3072), n = (int)(i % 3072), seg = n >> 10, nn = n & 1023; float v = 0.f;
          if (seg == 0) { if (k < 64) v = w2[k * 1024 + nn]; } else if (seg == 1) { if (k >= 64 && k < 128) v = a2[(k - 64) * 1024 + nn]; } else { if (k >= 128 && k < 288) v = g2[(k - 128) * 1024 + nn]; }
          wl[(size_t)n * 384 + k] = f2bf(v); } }
    { float* ada = (float*)(ws + WS_ADA); const float* cc = A->in[I_C]; const float* wa = A->in[I_WADA]; const float* ba = A->in[I_BADA]; LAS float* red = (LAS float*)lds;
      for (int item = blockIdx.x; item < 192; item += G) {
          const int cl = tid & 31, ks = tid >> 5, col = item * 32 + cl; float ac[8];
#pragma unroll
          for (int b = 0; b < 8; ++b) ac[b] = 0.f;
          for (int k = ks * 64; k < ks * 64 + 64; ++k) { const float w = wa[(size_t)k * 6144 + col];
#pragma unroll
              for (int b = 0; b < 8; ++b) ac[b] = fmaf(cc[b * 1024 + k], w, ac[b]); }
#pragma unroll
          for (int b = 0; b < 8; ++b) red[(ks * 8 + b) * 32 + cl] = ac[b];
          __syncthreads();
          if (tid < 256) { const int b = tid >> 5; float s = 0.f;
#pragma unroll
              for (int q = 0; q < 16; ++q) s += red[(q * 8 + b) * 32 + cl];
              ada[b * 6144 + col] = s + ba[col]; }
          __syncthreads();
      } }
}

__device__ __forceinline__ void p_ffn_weights(const int WV, kargs_t A, lds_t lds) {
    unsigned char* ws = A->ws;
    conv_job(WV, A->in[I_WUP], 5632, 0, 1024, (bf16_t*)(ws + WS_WUP), 1024, 0, 5632, lds);
    conv_job(WV, A->in[I_WDN], 1024, 0, 2816, (bf16_t*)(ws + WS_WDN), 2816, 0, 1024, lds);
}
template <bool ADA, bool OUTBF>
__device__ __forceinline__ void norm_rows(const int WV, const float* src, const float* w, const float* ada_sh, const float* ada_sc, void* dst, int nrows, int row0g) {
    const int tid_ = ltid(); const int lane = tid_ & 63, wid = tid_ >> 6;
    const int nw = gridDim.x * 8, gw = blockIdx.x * 8 + wid;
    const int per = (nrows + nw - 1) / nw, r_begin = gw * per, r_end = (r_begin + per < nrows) ? r_begin + per : nrows;
    f32x4 cw[4], cs[4], vn[4]; int cb = -1;
    if (r_begin < r_end) {
#pragma unroll
        for (int i = 0; i < 4; ++i) vn[i] = *(const f32x4*)(src + (size_t)r_begin * 1024 + 4 * (lane + 64 * i)); }
    for (int r = r_begin; r < r_end; ++r) {
        const int b = (row0g + r) >> 12;
        if (b != cb) { cb = b;
#pragma unroll
            for (int i = 0; i < 4; ++i) { const int c = 4 * (lane + 64 * i); cw[i] = *(const f32x4*)(w + c);
                if constexpr (ADA) { const f32x4 sc = *(const f32x4*)(ada_sc + (size_t)b * 6144 + c); cw[i] = cw[i] * (sc + 1.0f); cs[i] = *(const f32x4*)(ada_sh + (size_t)b * 6144 + c); } } }
        f32x4 v[4]; float ss = 0.f;
#pragma unroll
        for (int i = 0; i < 4; ++i) v[i] = vn[i];
        if (r + 1 < r_end) { const float* pn = src + (size_t)(r + 1) * 1024;
#pragma unroll
            for (int i = 0; i < 4; ++i) vn[i] = *(const f32x4*)(pn + 4 * (lane + 64 * i)); }
#pragma unroll
        for (int i = 0; i < 4; ++i) ss += v[i][0] * v[i][0] + v[i][1] * v[i][1] + v[i][2] * v[i][2] + v[i][3] * v[i][3];
#pragma unroll
        for (int o = 32; o >= 1; o >>= 1) ss += __shfl_xor(ss, o);
        const float rs = rsqrtf(ss * (1.0f / 1024.0f) + 1e-6f);
#pragma unroll
        for (int i = 0; i < 4; ++i) { const int c = 4 * (lane + 64 * i); f32x4 y = v[i] * rs * cw[i];
            if constexpr (ADA) y = y + cs[i];
            if constexpr (OUTBF) { u32x2 o; o.x = pk_bf16(y[0], y[1]); o.y = pk_bf16(y[2], y[3]); *(u32x2*)((bf16_t*)dst + (size_t)r * 1024 + c) = o; }
            else *(f32x4*)((float*)dst + (size_t)r * 1024 + c) = y; }
    }
}

__device__ __forceinline__ void lora_prep(const int WV, kargs_t A) {
    const bf16_t* prw = (const bf16_t*)(A->ws + WS_PRW); bf16_t* al = (bf16_t*)(A->ws + WS_ALORA); const float* mu = A->in[I_MU] + 3072;
    const size_t gtid = (size_t)blockIdx.x * NTHREADS + ltid(), gsz = (size_t)gridDim.x * NTHREADS;
    for (size_t it = gtid; it < (size_t)MTOK * 48; it += gsz) {
        const int row = (int)(it / 48), ch = (int)(it % 48); u32x4 o = (u32x4){0u, 0u, 0u, 0u};
        if (ch < 36) {
            const bf16_t* p = prw + (size_t)row * NRW + 3072 + ch * 8;
            const u32x4 cu = *(const u32x4*)p; u32x4 pv = (u32x4){0u, 0u, 0u, 0u}; if ((row & 4095) != 0) pv = *(const u32x4*)(p - NRW);
            const f32x4 m0 = *(const f32x4*)(mu + ch * 8), m1 = *(const f32x4*)(mu + ch * 8 + 4);
            float z[8], zp[8];
            z[0] = bf_lo(cu.x); z[1] = bf_hi(cu.x); z[2] = bf_lo(cu.y); z[3] = bf_hi(cu.y); z[4] = bf_lo(cu.z); z[5] = bf_hi(cu.z); z[6] = bf_lo(cu.w); z[7] = bf_hi(cu.w);
            zp[0] = bf_lo(pv.x); zp[1] = bf_hi(pv.x); zp[2] = bf_lo(pv.y); zp[3] = bf_hi(pv.y); zp[4] = bf_lo(pv.z); zp[5] = bf_hi(pv.z); zp[6] = bf_lo(pv.w); zp[7] = bf_hi(pv.w);
#pragma unroll
            for (int j = 0; j < 8; ++j) { const float m = j < 4 ? m0[j & 3] : m1[j & 3]; float s = z[j] + (zp[j] - z[j]) * m;
                if (ch < 8) s = tanhf(s); else if (ch >= 16) s = sigm(s);
                z[j] = s; }
            o.x = pk_bf16(z[0], z[1]); o.y = pk_bf16(z[2], z[3]); o.z = pk_bf16(z[4], z[5]); o.w = pk_bf16(z[6], z[7]);
        }
        *(u32x4*)(al + (size_t)row * 384 + ch * 8) = o;
    }
}

__device__ __forceinline__ float allred8(float x) { x += dppf<0xB1>(x); x += dppf<0x4E>(x); x += dppf<0x141>(x); return x; }
__device__ __forceinline__ void scan_phase(const int WV, kargs_t A, lds_t lds) {
    const bf16_t* prw = (const bf16_t*)(A->ws + WS_PRW); const bf16_t* ea = (const bf16_t*)(A->ws + WS_EA);
    bf16_t* Y = (bf16_t*)(A->ws + WS_Y); float* BS = (float*)(A->ws + WS_BS);
    LAS float* L = (LAS float*)lds;
    LAS float* SY = L + 22528;
    const int tid = ltid(); const bool scanw = (WV < 4);
    const int ltd = tid & 255, r8 = ltd >> 3, k8 = ltd & 7;
    for (int item = blockIdx.x; item < 256; item += gridDim.x) {
        const int half = item & 1, h = (item >> 1) & 15, b = item >> 5;
        const int cr = h * 64 + 8 * k8, cv = h * 64 + half * 32 + 4 * k8;
        f32x4 cmur[2], cmuk[2], ckkv[2], ckav[2], crkv[2];
#pragma unroll
        for (int q = 0; q < 2; ++q) { cmur[q] = *(const f32x4*)(A->in[I_MU] + cr + 4 * q); cmuk[q] = *(const f32x4*)(A->in[I_MU] + 1024 + cr + 4 * q);
            ckkv[q] = *(const f32x4*)(A->in[I_KK] + cr + 4 * q); ckav[q] = *(const f32x4*)(A->in[I_KA] + cr + 4 * q); crkv[q] = *(const f32x4*)(A->in[I_RK] + cr + 4 * q); }
        const f32x4 cmuv = *(const f32x4*)(A->in[I_MU] + 2048 + cv);
        auto produce = [&](const int cc, const int bufi) {
            const int t = cc * 32 + r8; const size_t row = (size_t)b * SEQ + t; const bf16_t* pr = prw + row * NRW; const bf16_t* pp = (t > 0) ? pr - NRW : pr;
            const u32x4 ur = *(const u32x4*)(pr + cr), uk = *(const u32x4*)(pr + 1024 + cr); u32x4 urp = *(const u32x4*)(pp + cr), ukp = *(const u32x4*)(pp + 1024 + cr);
            const u32x2 uv = *(const u32x2*)(pr + 2048 + cv); u32x2 uvp = *(const u32x2*)(pp + 2048 + cv);
            const u32x4 ue = *(const u32x4*)(ea + row * 2048 + cr), ua = *(const u32x4*)(ea + row * 2048 + 1024 + cr);
            if (t == 0) { urp = (u32x4){0u, 0u, 0u, 0u}; ukp = (u32x4){0u, 0u, 0u, 0u}; uvp = (u32x2){0u, 0u}; }
            const float zr[8] = {bf_lo(ur.x), bf_hi(ur.x), bf_lo(ur.y), bf_hi(ur.y), bf_lo(ur.z), bf_hi(ur.z), bf_lo(ur.w), bf_hi(ur.w)};
            const float zrp[8] = {bf_lo(urp.x), bf_hi(urp.x), bf_lo(urp.y), bf_hi(urp.y), bf_lo(urp.z), bf_hi(urp.z), bf_lo(urp.w), bf_hi(urp.w)};
            const float zk[8] = {bf_lo(uk.x), bf_hi(uk.x), bf_lo(uk.y), bf_hi(uk.y), bf_lo(uk.z), bf_hi(uk.z), bf_lo(uk.w), bf_hi(uk.w)};
            const float zkp[8] = {bf_lo(ukp.x), bf_hi(ukp.x), bf_lo(ukp.y), bf_hi(ukp.y), bf_lo(ukp.z), bf_hi(ukp.z), bf_lo(ukp.w), bf_hi(ukp.w)};
            const float ze[8] = {bf_lo(ue.x), bf_hi(ue.x), bf_lo(ue.y), bf_hi(ue.y), bf_lo(ue.z), bf_hi(ue.z), bf_lo(ue.w), bf_hi(ue.w)};
            const float za[8] = {bf_lo(ua.x), bf_hi(ua.x), bf_lo(ua.y), bf_hi(ua.y), bf_lo(ua.z), bf_hi(ua.z), bf_lo(ua.w), bf_hi(ua.w)};
            float r_[8], k_[8], e_[8], a_[8], kk_[8]; float n2 = 0.f;
#pragma unroll
            for (int i = 0; i < 8; ++i) {
                r_[i] = zr[i] + (zrp[i] - zr[i]) * cmur[i >> 2][i & 3]; k_[i] = zk[i] + (zkp[i] - zk[i]) * cmuk[i >> 2][i & 3];
                e_[i] = ze[i]; a_[i] = za[i];
                kk_[i] = k_[i] * ckkv[i >> 2][i & 3]; n2 = fmaf(kk_[i], kk_[i], n2); }
            n2 = allred8(n2); const float inv = __builtin_amdgcn_rcpf(fmaxf(__builtin_amdgcn_sqrtf(n2), 1e-12f));
            float o_r[8], o_w[8], o_k[8], o_a[8], o_b[8]; float bsum = 0.f;
#pragma unroll
            for (int i = 0; i < 8; ++i) { const float kn = kk_[i] * inv; const float km = k_[i] * (1.0f + (a_[i] - 1.0f) * ckav[i >> 2][i & 3]);
                o_r[i] = r_[i]; o_w[i] = __expf(-e_[i]); o_k[i] = km; o_a[i] = -kn; o_b[i] = kn * a_[i]; bsum = fmaf(r_[i] * km, crkv[i >> 2][i & 3], bsum); }
            bsum = allred8(bsum);
            LAS float* Bf = L + bufi * 11264 + r8 * 64 + 8 * k8;
#pragma unroll
            for (int q = 0; q < 2; ++q) {
                *(LAS f32x4*)(Bf + 4 * q) = (f32x4){o_r[4 * q], o_r[4 * q + 1], o_r[4 * q + 2], o_r[4 * q + 3]};
                *(LAS f32x4*)(Bf + 2048 + 4 * q) = (f32x4){o_w[4 * q], o_w[4 * q + 1], o_w[4 * q + 2], o_w[4 * q + 3]};
                *(LAS f32x4*)(Bf + 4096 + 4 * q) = (f32x4){o_k[4 * q], o_k[4 * q + 1], o_k[4 * q + 2], o_k[4 * q + 3]};
                *(LAS f32x4*)(Bf + 6144 + 4 * q) = (f32x4){o_a[4 * q], o_a[4 * q + 1], o_a[4 * q + 2], o_a[4 * q + 3]};
                *(LAS f32x4*)(Bf + 8192 + 4 * q) = (f32x4){o_b[4 * q], o_b[4 * q + 1], o_b[4 * q + 2], o_b[4 * q + 3]}; }
            { const float v0 = bf_lo(uv.x), v1 = bf_hi(uv.x), v2 = bf_lo(uv.y), v3 = bf_hi(uv.y);
              *(LAS f32x4*)(L + bufi * 11264 + 10240 + r8 * 32 + 4 * k8) = (f32x4){v0 + (bf_lo(uvp.x) - v0) * cmuv[0], v1 + (bf_hi(uvp.x) - v1) * cmuv[1], v2 + (bf_lo(uvp.y) - v2) * cmuv[2], v3 + (bf_hi(uvp.y) - v3) * cmuv[3]}; }
            if (half == 0 && k8 == 0) BS[row * 16 + h] = bsum;
        };
        auto ystore = [&](const int cc) {
            const LAS float* syr = SY + (cc % 3) * 1024 + r8 * 32 + 4 * k8; const f32x4 yv = *(const LAS f32x4*)syr;
            u32x2 w; w.x = pk_bf16(yv[0], yv[1]); w.y = pk_bf16(yv[2], yv[3]);
            *(u32x2*)(Y + ((size_t)(b * 16 + h) * 4096 + cc * 32 + r8) * 64 + half * 32 + 4 * k8) = w;
        };
        __syncthreads();
        if (!scanw) produce(0, 0);
        __syncthreads();
        f32x2 S0 = {0.f, 0.f}, S1 = {0.f, 0.f}, S2 = {0.f, 0.f}, S3 = {0.f, 0.f};
        float yq = 0.f, yreg = 0.f;
        struct StepIn { f32x4 r0, r1, w0, w1, k0, k1, a0, a1, b0, b1; float v; };
#define SCAN_LDS(R, t) do { const unsigned ab_ = (unsigned)(size_t)(Bc + (t) * 64 + 8 * k8), av_ = (unsigned)(size_t)(Bc + (t) * 32 + r8); \
            asm volatile("ds_read_b128 %0, %11 offset:24576\n\tds_read_b128 %1, %11 offset:24592\n\tds_read_b128 %2, %11 offset:32768\n\tds_read_b128 %3, %11 offset:32784\n\t" \
                         "ds_read_b32 %10, %12 offset:40960\n\tds_read_b128 %4, %11 offset:16384\n\tds_read_b128 %5, %11 offset:16400\n\t" \
                         "ds_read_b128 %6, %11 offset:8192\n\tds_read_b128 %7, %11 offset:8208\n\tds_read_b128 %8, %11\n\tds_read_b128 %9, %11 offset:16" \
                         : "=&v"(R.a0), "=&v"(R.a1), "=&v"(R.b0), "=&v"(R.b1), "=&v"(R.k0), "=&v"(R.k1), "=&v"(R.w0), "=&v"(R.w1), "=&v"(R.r0), "=&v"(R.r1), "=&v"(R.v) : "v"(ab_), "v"(av_) : "memory"); } while (0)
#define SCAN_WAIT(R) asm volatile("s_waitcnt lgkmcnt(11)" : "+v"(R.a0), "+v"(R.a1), "+v"(R.b0), "+v"(R.b1), "+v"(R.k0), "+v"(R.k1), "+v"(R.w0), "+v"(R.w1), "+v"(R.r0), "+v"(R.r1), "+v"(R.v) :: "memory")
#define P2(v4, i) ((f32x2){v4[2 * (i)], v4[2 * (i) + 1]})
#define SCAN_STEP(R, t) do { \
            f32x2 pa = S0 * P2(R.a0, 0), pb = S1 * P2(R.a0, 1); pa = S2 * P2(R.a1, 0) + pa; pb = S3 * P2(R.a1, 1) + pb; \
            float sa = (pa.x + pb.x) + (pa.y + pb.y); float yy = yq; \
            sa += dppf<0xB1>(sa); yy += dppf<0xB1>(yy); sa += dppf<0x4E>(sa); yy += dppf<0x4E>(yy); sa += dppf<0x141>(sa); yy += dppf<0x141>(yy); \
            yreg = (k8 == (((t) + 7) & 7)) ? yy : yreg; \
            const f32x2 sa2 = {sa, sa}, vv2 = {R.v, R.v}; \
            f32x2 t0 = vv2 * P2(R.k0, 0), t1 = vv2 * P2(R.k0, 1), t2 = vv2 * P2(R.k1, 0), t3 = vv2 * P2(R.k1, 1); \
            t0 = sa2 * P2(R.b0, 0) + t0; t1 = sa2 * P2(R.b0, 1) + t1; t2 = sa2 * P2(R.b1, 0) + t2; t3 = sa2 * P2(R.b1, 1) + t3; \
            S0 = S0 * P2(R.w0, 0) + t0; S1 = S1 * P2(R.w0, 1) + t1; S2 = S2 * P2(R.w1, 0) + t2; S3 = S3 * P2(R.w1, 1) + t3; \
            f32x2 qa = S0 * P2(R.r0, 0); qa = S1 * P2(R.r0, 1) + qa; qa = S2 * P2(R.r1, 0) + qa; qa = S3 * P2(R.r1, 1) + qa; \
            yq = qa.x + qa.y; } while (0)
        for (int c = 0; c < 128; ++c) {
            if (scanw) {
                const LAS float* Bc = L + (c & 1) * 11264;
                LAS float* syc = SY + (c % 3) * 1024; LAS float* syp = SY + ((c + 2) % 3) * 1024;
                StepIn R0, R1;
                SCAN_LDS(R0, 0);
#pragma unroll 4
                for (int t = 0; t < 32; t += 2) {
                    SCAN_LDS(R1, t + 1); SCAN_WAIT(R0); SCAN_STEP(R0, t);
                    if ((t & 7) == 0) { if (t == 0) { if (c > 0) syp[(24 + k8) * 32 + r8] = yreg; } else syc[(t - 8 + k8) * 32 + r8] = yreg; }
                    SCAN_LDS(R0, (t + 2) & 31); SCAN_WAIT(R1); SCAN_STEP(R1, t + 1);
                }
                asm volatile("s_waitcnt lgkmcnt(0)" : "+v"(R0.a0), "+v"(R0.a1), "+v"(R0.b0), "+v"(R0.b1), "+v"(R0.k0), "+v"(R0.k1), "+v"(R0.w0), "+v"(R0.w1), "+v"(R0.r0), "+v"(R0.r1), "+v"(R0.v) :: "memory");
            } else {
                if (c >= 2) ystore(c - 2);
                if (c + 1 < 128) produce(c + 1, (c + 1) & 1);
            }
            __syncthreads();
        }
        if (scanw) { const float yy = allred8(yq); yreg = (k8 == 7) ? yy : yreg; SY[(127 % 3) * 1024 + (24 + k8) * 32 + r8] = yreg; }
        __syncthreads();
        if (!scanw) { ystore(126); ystore(127); }
#undef SCAN_LDS
#undef SCAN_STEP
#undef P2
    }
}

__device__ __forceinline__ void post_phase(const int WV, kargs_t A) {
    const bf16_t* prw = (const bf16_t*)(A->ws + WS_PRW); const bf16_t* Y = (const bf16_t*)(A->ws + WS_Y); const bf16_t* Gg = (const bf16_t*)(A->ws + WS_G);
    const float* BS = (const float*)(A->ws + WS_BS); bf16_t* RWO = (bf16_t*)(A->ws + WS_RWO);
    const size_t gtid = (size_t)blockIdx.x * NTHREADS + ltid(), gsz = (size_t)gridDim.x * NTHREADS;
    constexpr int RR = 64;
    for (size_t it = gtid; it < (size_t)(MTOK / RR) * 256; it += gsz) {
        const int cg = (int)(it & 255), h = cg >> 4, kq = cg & 15, c = 4 * cg; const size_t row0 = (it >> 8) * RR; const int b = (int)(row0 >> 12), t0 = (int)(row0 & 4095);
        const f32x4 muv = *(const f32x4*)(A->in[I_MU] + 2048 + c), lw = *(const f32x4*)(A->in[I_LNW] + c), lb = *(const f32x4*)(A->in[I_LNB] + c);
        const bf16_t* yp = Y + ((size_t)(b * 16 + h) * 4096 + t0) * 64 + 4 * kq;
        u32x2 vp = (u32x2){0u, 0u}; if (t0 != 0) vp = *(const u32x2*)(prw + (row0 - 1) * NRW + 2048 + c);
#pragma unroll 4
        for (int rr = 0; rr < RR; ++rr) {
            const size_t row = row0 + rr;
            const u32x2 yu = *(const u32x2*)(yp + (size_t)rr * 64); const u32x2 vu = *(const u32x2*)(prw + row * NRW + 2048 + c);
            const u32x2 gu = *(const u32x2*)(Gg + row * 1024 + c); const float bs = BS[row * 16 + h];
            float y[4] = {bf_lo(yu.x), bf_hi(yu.x), bf_lo(yu.y), bf_hi(yu.y)};
            const float mean = allred16((y[0] + y[1]) + (y[2] + y[3])) * (1.0f / 64.0f);
            float q = 0.f;
#pragma unroll
            for (int i = 0; i < 4; ++i) { y[i] -= mean; q = fmaf(y[i], y[i], q); }
            const float rstd = rsqrtf(allred16(q) * (1.0f / 64.0f) + 64e-5f);
            const float vc[4] = {bf_lo(vu.x), bf_hi(vu.x), bf_lo(vu.y), bf_hi(vu.y)}, vq[4] = {bf_lo(vp.x), bf_hi(vp.x), bf_lo(vp.y), bf_hi(vp.y)}, gg[4] = {bf_lo(gu.x), bf_hi(gu.x), bf_lo(gu.y), bf_hi(gu.y)};
            float o[4];
#pragma unroll
            for (int i = 0; i < 4; ++i) { const float v = vc[i] + (vq[i] - vc[i]) * muv[i]; o[i] = (y[i] * rstd * lw[i] + lb[i] + bs * v) * gg[i]; }
            u32x2 w; w.x = pk_bf16(o[0], o[1]); w.y = pk_bf16(o[2], o[3]); *(u32x2*)(RWO + row * 1024 + c) = w;
            vp = vu;
        }
    }
}

__device__ __forceinline__ void attn_phase(const int WV, kargs_t A, lds_t lds) {
    const bf16_t* PATT = (const bf16_t*)(A->ws + WS_PATT); bf16_t* ATTO = (bf16_t*)(A->ws + WS_ATTO); float* LSE = (float*)(A->ws + WS_LSE);
    lds_t Ks = lds; lds_t Vt = lds + 36864;
    const int tid = ltid(), wid = tid >> 6, lane = tid & 63, fr = lane & 15, fq = lane >> 4, T0 = wid & ~1;
    u32x4 pk_[4], pv_[4]; bf16x8 pq_[2];
#define ATT_DECODE(u) const int idx = (u) & 31, h = ((u) >> 5) & 7, gb = (u) >> 8, g = gb % 3, bl = gb / 3; \
        const int dl = (g == 0) ? 0 : (g == 1 ? 2 : 4); const int r = idx & ((1 << dl) - 1), n = idx >> dl; \
        const bf16_t* base = PATT + (size_t)(bl * SEQ) * 4608 + g * 1536 + h * 64;
#define ATT_LOAD(u) do { ATT_DECODE(u) \
        _Pragma("unroll") for (int i = 0; i < 4; ++i) { const int c = tid + 512 * i, key = c >> 3, part = c & 7; int j = 128 * n - 128 + key; j = j < 0 ? 0 : j; const size_t pos = ((size_t)j << dl) + r; \
            pk_[i] = *(const u32x4*)(base + pos * 4608 + 512 + part * 8); pv_[i] = *(const u32x4*)(base + pos * 4608 + 1024 + part * 8); } \
        { const int qi_ = 16 * wid + fr; const size_t pos = ((size_t)(128 * n + qi_) << dl) + r; pq_[0] = *(const bf16x8*)(base + pos * 4608 + fq * 8); pq_[1] = *(const bf16x8*)(base + pos * 4608 + 32 + fq * 8); } } while (0)
    if ((int)blockIdx.x < 3072) ATT_LOAD((int)blockIdx.x);
    for (int u = blockIdx.x; u < 3072; u += gridDim.x) {
        ATT_DECODE(u) (void)base;
        __syncthreads();
#pragma unroll
        for (int i = 0; i < 4; ++i) { const int c = tid + 512 * i, key = c >> 3, part = c & 7;
            *(LAS u32x4*)(Ks + key * 144 + part * 16) = pk_[i];
            *(LAS u32x4*)(Vt + key * 144 + part * 16) = pv_[i]; }
        const int qi = 16 * wid + fr; bf16x8 qf[2]; qf[0] = pq_[0]; qf[1] = pq_[1];
        __syncthreads();
        if (u + (int)gridDim.x < 3072) ATT_LOAD(u + (int)gridDim.x);
        f32x4 st[10]; float m = -INFINITY;
#pragma unroll
        for (int T = 0; T < 10; ++T) { const int Tt = T0 + T;
            const bf16x8 k0 = *(const LAS bf16x8*)(Ks + (16 * Tt + fr) * 144 + fq * 16), k1 = *(const LAS bf16x8*)(Ks + (16 * Tt + fr) * 144 + 64 + fq * 16);
            f32x4 acc = (f32x4){0.f, 0.f, 0.f, 0.f};
            acc = __builtin_amdgcn_mfma_f32_16x16x32_bf16(k0, qf[0], acc, 0, 0, 0); acc = __builtin_amdgcn_mfma_f32_16x16x32_bf16(k1, qf[1], acc, 0, 0, 0);
            const int rel = Tt - wid;
            if (rel < 0 || rel > 8 || (n == 0 && Tt < 8)) { acc = (f32x4){-INFINITY, -INFINITY, -INFINITY, -INFINITY}; }
            else if (rel == 0) {
#pragma unroll
                for (int rg = 0; rg < 4; ++rg) { const float s = (4 * fq + rg >= fr) ? acc[rg] * 0.125f : -INFINITY; acc[rg] = s; m = fmaxf(m, s); } }
            else if (rel == 8) {
#pragma unroll
                for (int rg = 0; rg < 4; ++rg) { const float s = (4 * fq + rg <= fr) ? acc[rg] * 0.125f : -INFINITY; acc[rg] = s; m = fmaxf(m, s); } }
            else {
#pragma unroll
                for (int rg = 0; rg < 4; ++rg) { const float s = acc[rg] * 0.125f; acc[rg] = s; m = fmaxf(m, s); } }
            st[T] = acc; }
        m = fmaxf(m, __shfl_xor(m, 16)); m = fmaxf(m, __shfl_xor(m, 32));
        float den = 0.f;
#pragma unroll
        for (int T = 0; T < 10; ++T)
#pragma unroll
            for (int rg = 0; rg < 4; ++rg) { const float p = __expf(st[T][rg] - m); st[T][rg] = p; den += p; }
        den += __shfl_xor(den, 16); den += __shfl_xor(den, 32);
        f32x4 o[4];
#pragma unroll
        for (int nt = 0; nt < 4; ++nt) o[nt] = (f32x4){0.f, 0.f, 0.f, 0.f};
        const unsigned vaddr = (unsigned)(size_t)Vt + (unsigned)((4 * fq + (fr >> 2)) * 144 + (fr & 3) * 8);
#pragma unroll
        for (int s2 = 0; s2 < 5; ++s2) { const int Ta = T0 + 2 * s2;
            u32x4 pw; pw.x = pk_bf16(st[2 * s2][0], st[2 * s2][1]); pw.y = pk_bf16(st[2 * s2][2], st[2 * s2][3]); pw.z = pk_bf16(st[2 * s2 + 1][0], st[2 * s2 + 1][1]); pw.w = pk_bf16(st[2 * s2 + 1][2], st[2 * s2 + 1][3]);
            const bf16x8 pa = __builtin_bit_cast(bf16x8, pw);
            const unsigned va = vaddr + (unsigned)(16 * Ta * 144);
            u32x2 a0, a1, a2, a3, b0, b1, b2, b3;
            asm volatile("ds_read_b64_tr_b16 %0, %8\n\tds_read_b64_tr_b16 %1, %8 offset:32\n\tds_read_b64_tr_b16 %2, %8 offset:64\n\tds_read_b64_tr_b16 %3, %8 offset:96\n\t"
                         "ds_read_b64_tr_b16 %4, %8 offset:2304\n\tds_read_b64_tr_b16 %5, %8 offset:2336\n\tds_read_b64_tr_b16 %6, %8 offset:2368\n\tds_read_b64_tr_b16 %7, %8 offset:2400\n\t"
                         "s_waitcnt lgkmcnt(0)"
                         : "=&v"(a0), "=&v"(a1), "=&v"(a2), "=&v"(a3), "=&v"(b0), "=&v"(b1), "=&v"(b2), "=&v"(b3) : "v"(va) : "memory");
            { u32x4 vw; vw.x = a0.x; vw.y = a0.y; vw.z = b0.x; vw.w = b0.y; o[0] = __builtin_amdgcn_mfma_f32_16x16x32_bf16(pa, __builtin_bit_cast(bf16x8, vw), o[0], 0, 0, 0); }
            { u32x4 vw; vw.x = a1.x; vw.y = a1.y; vw.z = b1.x; vw.w = b1.y; o[1] = __builtin_amdgcn_mfma_f32_16x16x32_bf16(pa, __builtin_bit_cast(bf16x8, vw), o[1], 0, 0, 0); }
            { u32x4 vw; vw.x = a2.x; vw.y = a2.y; vw.z = b2.x; vw.w = b2.y; o[2] = __builtin_amdgcn_mfma_f32_16x16x32_bf16(pa, __builtin_bit_cast(bf16x8, vw), o[2], 0, 0, 0); }
            { u32x4 vw; vw.x = a3.x; vw.y = a3.y; vw.z = b3.x; vw.w = b3.y; o[3] = __builtin_amdgcn_mfma_f32_16x16x32_bf16(pa, __builtin_bit_cast(bf16x8, vw), o[3], 0, 0, 0); } }
        const float inv = __builtin_amdgcn_rcpf(den);
        if (fq == 0) { const size_t pos = ((size_t)(128 * n + qi) << dl) + r; LSE[((size_t)g * CH + (size_t)bl * SEQ + pos) * 8 + h] = m + __logf(den); }
#pragma unroll
        for (int rg = 0; rg < 4; ++rg) { const float iv = __shfl(inv, 4 * fq + rg); const int q = 16 * wid + 4 * fq + rg; const size_t pos = ((size_t)(128 * n + q) << dl) + r;
            bf16_t* op = ATTO + ((size_t)g * CH + (size_t)bl * SEQ + pos) * 512 + h * 64 + fr;
#pragma unroll
            for (int nt = 0; nt < 4; ++nt) op[16 * nt] = f2bf(o[nt][rg] * iv); }
    }
#undef ATT_DECODE
#undef ATT_LOAD
}

__device__ __forceinline__ void combine_phase(const int WV, kargs_t A, const size_t roff) {
    const bf16_t* ATTO = (const bf16_t*)(A->ws + WS_ATTO); const float* LSE = (const float*)(A->ws + WS_LSE); bf16_t* ATTM = (bf16_t*)(A->ws + WS_ATTM) + roff * 512;
    const size_t gtid = (size_t)blockIdx.x * NTHREADS + ltid(), gsz = (size_t)gridDim.x * NTHREADS;
    for (size_t it = gtid; it < (size_t)CH * 64; it += gsz) {
        const size_t row = it >> 6; const int ch = (int)(it & 63), h = ch >> 3;
        const float l0 = LSE[(0 * (size_t)CH + row) * 8 + h], l1 = LSE[(1 * (size_t)CH + row) * 8 + h], l2 = LSE[(2 * (size_t)CH + row) * 8 + h];
        const float mx = fmaxf(l0, fmaxf(l1, l2)); float w0 = __expf(l0 - mx), w1 = __expf(l1 - mx), w2 = __expf(l2 - mx); const float is = __builtin_amdgcn_rcpf(w0 + w1 + w2); w0 *= is; w1 *= is; w2 *= is;
        const u32x4 a0 = *(const u32x4*)(ATTO + (0 * (size_t)CH + row) * 512 + ch * 8), a1 = *(const u32x4*)(ATTO + (1 * (size_t)CH + row) * 512 + ch * 8), a2 = *(const u32x4*)(ATTO + (2 * (size_t)CH + row) * 512 + ch * 8);
        u32x4 o;
        o.x = pk_bf16(w0 * bf_lo(a0.x) + w1 * bf_lo(a1.x) + w2 * bf_lo(a2.x), w0 * bf_hi(a0.x) + w1 * bf_hi(a1.x) + w2 * bf_hi(a2.x));
        o.y = pk_bf16(w0 * bf_lo(a0.y) + w1 * bf_lo(a1.y) + w2 * bf_lo(a2.y), w0 * bf_hi(a0.y) + w1 * bf_hi(a1.y) + w2 * bf_hi(a2.y));
        o.z = pk_bf16(w0 * bf_lo(a0.z) + w1 * bf_lo(a1.z) + w2 * bf_lo(a2.z), w0 * bf_hi(a0.z) + w1 * bf_hi(a1.z) + w2 * bf_hi(a2.z));
        o.w = pk_bf16(w0 * bf_lo(a0.w) + w1 * bf_lo(a1.w) + w2 * bf_lo(a2.w), w0 * bf_hi(a0.w) + w1 * bf_hi(a1.w) + w2 * bf_hi(a2.w));
        *(u32x4*)(ATTM + row * 512 + ch * 8) = o;
    }
}

constexpr int CONV_RS = 32;
__device__ __forceinline__ void halo_phase(const int WV, kargs_t A) {
    const bf16_t* U = (const bf16_t*)(A->ws + WS_U); bf16_t* HALO = (bf16_t*)(A->ws + WS_HALO);
    const size_t gtid = (size_t)blockIdx.x * NTHREADS + ltid(), gsz = (size_t)gridDim.x * NTHREADS;
    for (size_t it = gtid; it < (size_t)(MTOK / CONV_RS) * 2 * 704; it += gsz) {
        const int ch = (int)(it % 704); const size_t sr = it / 704; const int which = (int)(sr & 1); const size_t seg = sr >> 1; const size_t row0 = seg * CONV_RS;
        u32x4 v = (u32x4){0u, 0u, 0u, 0u};
        if ((row0 & 4095) != 0) v = *(const u32x4*)(U + (row0 - 1 - which) * 5632 + ch * 8);
        *(u32x4*)(HALO + (seg * 2 + which) * 5632 + ch * 8) = v;
    }
}
__device__ __forceinline__ void conv_phase(const int WV, kargs_t A, unsigned* bar, volatile LAS unsigned* bst, const bool one_launch) {
    bf16_t* U = (bf16_t*)(A->ws + WS_U); bf16_t* HALO = (bf16_t*)(A->ws + WS_HALO); const float* cw = A->in[I_CONVW]; const float* cb = A->in[I_CONVB];
    const size_t gtid = (size_t)blockIdx.x * NTHREADS + ltid(), gsz = (size_t)gridDim.x * NTHREADS;
    constexpr int R = CONV_RS; constexpr int MAXIT = 3;
    const size_t nitems = (size_t)(MTOK / R) * 352;
    const bool fits = nitems <= (size_t)MAXIT * gsz;
    if (one_launch && !fits) {
        for (size_t it = gtid; it < (size_t)(MTOK / R) * 2 * 704; it += gsz) { const int ch = (int)(it % 704); const size_t sr = it / 704; const int which = (int)(sr & 1); const size_t seg = sr >> 1; const size_t row0 = seg * R;
            u32x4 v = (u32x4){0u, 0u, 0u, 0u}; if ((row0 & 4095) != 0) v = *(const u32x4*)(U + (row0 - 1 - which) * 5632 + ch * 8);
            *(u32x4*)(HALO + (seg * 2 + which) * 5632 + ch * 8) = v; }
        xcd_barrier(WV, bar, bst);
    }
    const bool from_u = one_launch && fits;
    auto process = [&](const size_t it, const u32x4 (&hh1)[2], const u32x4 (&hh2)[2]) {
        const size_t seg = it / 352; const int j = (int)(it % 352) * 8; const size_t row0 = seg * R;
        f32x4 wb[2][2], w0[2][2], w1[2][2], w2[2][2];
#pragma unroll
        for (int s2 = 0; s2 < 2; ++s2)
#pragma unroll
            for (int q = 0; q < 2; ++q) { const int c = s2 * DFF + j + 4 * q; wb[s2][q] = *(const f32x4*)(cb + c); w0[s2][q] = *(const f32x4*)(cw + c); w1[s2][q] = *(const f32x4*)(cw + 5632 + c); w2[s2][q] = *(const f32x4*)(cw + 2 * 5632 + c); }
        u32x4 p1[2], p2[2];
#pragma unroll
        for (int s2 = 0; s2 < 2; ++s2) { p1[s2] = hh1[s2]; p2[s2] = hh2[s2]; }
#pragma unroll 4
        for (int rr = 0; rr < R; ++rr) {
            const size_t row = row0 + rr; u32x4 u0[2]; float res[2][8];
#pragma unroll
            for (int s2 = 0; s2 < 2; ++s2) u0[s2] = *(const u32x4*)(U + row * 5632 + s2 * DFF + j);
#pragma unroll
            for (int s2 = 0; s2 < 2; ++s2) {
                const float x0[8] = {bf_lo(u0[s2].x), bf_hi(u0[s2].x), bf_lo(u0[s2].y), bf_hi(u0[s2].y), bf_lo(u0[s2].z), bf_hi(u0[s2].z), bf_lo(u0[s2].w), bf_hi(u0[s2].w)};
                const float x1[8] = {bf_lo(p1[s2].x), bf_hi(p1[s2].x), bf_lo(p1[s2].y), bf_hi(p1[s2].y), bf_lo(p1[s2].z), bf_hi(p1[s2].z), bf_lo(p1[s2].w), bf_hi(p1[s2].w)};
                const float x2[8] = {bf_lo(p2[s2].x), bf_hi(p2[s2].x), bf_lo(p2[s2].y), bf_hi(p2[s2].y), bf_lo(p2[s2].z), bf_hi(p2[s2].z), bf_lo(p2[s2].w), bf_hi(p2[s2].w)};
#pragma unroll
                for (int q = 0; q < 2; ++q)
#pragma unroll
                    for (int i = 0; i < 4; ++i) res[s2][4 * q + i] = wb[s2][q][i] + w0[s2][q][i] * x2[4 * q + i] + w1[s2][q][i] * x1[4 * q + i] + w2[s2][q][i] * x0[4 * q + i];
                p2[s2] = p1[s2]; p1[s2] = u0[s2];
            }
            float o[8];
#pragma unroll
            for (int i = 0; i < 8; ++i) { const float gt = res[0][i]; o[i] = gt * sigm(gt) * res[1][i]; }
            u32x4 w; w.x = pk_bf16(o[0], o[1]); w.y = pk_bf16(o[2], o[3]); w.z = pk_bf16(o[4], o[5]); w.w = pk_bf16(o[6], o[7]);
            *(u32x4*)(U + row * 5632 + j) = w;
        }
    };
    auto load_halo = [&](const size_t it, u32x4 (&hh1)[2], u32x4 (&hh2)[2], const bool fu) {
        const size_t seg = it / 352; const int j = (int)(it % 352) * 8; const size_t row0 = seg * R;
#pragma unroll
        for (int s2 = 0; s2 < 2; ++s2) { hh1[s2] = (u32x4){0u, 0u, 0u, 0u}; hh2[s2] = (u32x4){0u, 0u, 0u, 0u};
            if (fu) { if ((row0 & 4095) != 0) { hh1[s2] = *(const u32x4*)(U + (row0 - 1) * 5632 + s2 * DFF + j); hh2[s2] = *(const u32x4*)(U + (row0 - 2) * 5632 + s2 * DFF + j); } }
            else { hh1[s2] = *(const u32x4*)(HALO + (seg * 2 + 0) * 5632 + s2 * DFF + j); hh2[s2] = *(const u32x4*)(HALO + (seg * 2 + 1) * 5632 + s2 * DFF + j); } }
    };
    u32x4 h1[MAXIT][2], h2[MAXIT][2];
#pragma unroll
    for (int k = 0; k < MAXIT; ++k) { const size_t it = gtid + (size_t)k * gsz; if (it < nitems) load_halo(it, h1[k], h2[k], from_u); }
    if (from_u) xcd_barrier(WV, bar, bst);
#pragma unroll
    for (int k = 0; k < MAXIT; ++k) { const size_t it = gtid + (size_t)k * gsz; if (it < nitems) process(it, h1[k], h2[k]); }
    for (size_t it = gtid + (size_t)MAXIT * gsz; it < nitems; it += gsz) { u32x4 a1[2], a2[2]; load_halo(it, a1, a2, false); process(it, a1, a2); }
}

template <int MODE> __device__ __forceinline__ void gemm_call(const int WV, lds_t lds, const pg8::Gemm g, const pg8::EpiArgs ea) {
    pg8::StaticOrder S; S.init(g.M, g.N, (int)gridDim.x, (int)blockIdx.x); pg8::Epi<MODE> E; E.a = ea; pg8::gemm_phase(WV, lds, g, S, E);
}
template <unsigned KM> __global__ void __launch_bounds__(NTHREADS, 2) fwd_kernel(Args Aval) {
    extern __shared__ __attribute__((aligned(16))) unsigned char lds_raw[];
    lds_t lds = (lds_t)lds_raw;
    const kargs_t A0 = (kargs_t)__builtin_amdgcn_kernarg_segment_ptr();
    const int WV = __builtin_amdgcn_readfirstlane(threadIdx.x >> 6);
    const int lo = A0->ph_lo, hi = A0->ph_hi; int ph = 0;
    unsigned* const bar = (unsigned*)(A0->ws + WS_BAR);
    volatile LAS unsigned* const bst = (volatile LAS unsigned*)(lds + 131072);
    if (hi > N_PHASES) cg::this_grid().sync();
    if (hi - lo > 1) {
        if (ltid() == 0) { bst[0] = 0u; bst[1] = 0u; (void)xb_add(&bar[XB_XCNT(xb_xcc_id())], 1u); }
        __syncthreads();
    }
    const int G = gridDim.x, bid = blockIdx.x;
#ifndef REP_MASK
#define REP_MASK 0u
#endif
#ifndef KIND_MASK
#define KIND_MASK 0xFFFFFFFFu
#endif
#define PH_BEGIN(k) if (ph >= lo && ph < hi) { if constexpr (((KM) >> (k)) & 1u) { for (int rep_ = 0; rep_ < ((((REP_MASK) >> (k)) & 1u) ? 2 : 1); ++rep_) { if (rep_) xcd_barrier(WV, bar, bst); const kargs_t A = launder_args(A0); unsigned char* const ws = A->ws; const float* const ada = (const float*)(ws + WS_ADA); (void)ada;
#define PH_END } } if (ph + 1 < hi) { xcd_barrier(WV, bar, bst); } } ++ph;
    using namespace pg8;
#ifdef PROBE_SYNCS
    if (hi - lo > 1) { for (int i_ = 0; i_ < PROBE_SYNCS; ++i_) cg::this_grid().sync(); }
#endif
    PH_BEGIN(0) p0_weights(WV, A, lds); PH_END
    PH_BEGIN(1) norm_rows<true, true>(WV, A->in[I_X], A->in[I_N1W], ada + 0, ada + 1024, ws + WS_H1, MTOK, 0); PH_END
    PH_BEGIN(2) { Gemm g{(const bf16_t*)(ws + WS_H1), (const bf16_t*)(ws + WS_WINRW), MTOK, NRW, 1024, 1024, 1024}; EpiArgs ea{}; ea.o0 = (bf16_t*)(ws + WS_PRW); ea.ld0 = NRW; ea.ncol0 = 1 << 30; gemm_call<EP_BF16>(WV, lds, g, ea); } PH_END
    PH_BEGIN(3) lora_prep(WV, A); PH_END
    PH_BEGIN(4) { Gemm g{(const bf16_t*)(ws + WS_ALORA), (const bf16_t*)(ws + WS_WLORA), MTOK, 2048, 256, 384, 384}; EpiArgs ea{}; ea.o0 = (bf16_t*)(ws + WS_EA); ea.ld0 = 2048; ea.p0 = A->in[I_W0]; ea.p1 = A->in[I_A0]; gemm_call<EP_EA>(WV, lds, g, ea); } PH_END
    PH_BEGIN(5) scan_phase(WV, A, lds); PH_END
    PH_BEGIN(6) { Gemm g{(const bf16_t*)(ws + WS_ALORA) + 128, (const bf16_t*)(ws + WS_WLORA) + (size_t)2048 * 384 + 128, MTOK, 1024, 256, 384, 384}; EpiArgs ea{}; ea.o0 = (bf16_t*)(ws + WS_G); ea.ld0 = 1024; ea.ncol0 = 1 << 30; gemm_call<EP_BF16>(WV, lds, g, ea); } PH_END
    PH_BEGIN(7) post_phase(WV, A); PH_END
    for (int ck = 0; ck < 2; ++ck) {
        const size_t roff = (size_t)ck * CH;
        if (ck == 0) { PH_BEGIN(8) norm_rows<true, true>(WV, A->in[I_X], A->in[I_N1W], ada + 0, ada + 1024, ws + WS_H1C, CH, 0); PH_END }
        PH_BEGIN(9) { Gemm g{(const bf16_t*)(ws + WS_H1C), (const bf16_t*)(ws + WS_WINAG), CH, NAG, 1024, 1024, 1024}; EpiArgs ea{}; ea.o0 = (bf16_t*)(ws + WS_PATT); ea.ld0 = 4608; ea.ncol0 = 4608; ea.o1 = (bf16_t*)(ws + WS_PGATE) + roff * 2048; ea.ld1 = 2048; gemm_call<EP_BF16>(WV, lds, g, ea); } PH_END
        PH_BEGIN(10) attn_phase(WV, A, lds); PH_END
        PH_BEGIN(11) combine_phase(WV, A, roff);
                     if (ck == 0) norm_rows<true, true>(WV, A->in[I_X] + (size_t)CH * 1024, A->in[I_N1W], ada + 0, ada + 1024, ws + WS_H1C, CH, CH); PH_END
    }
    PH_BEGIN(12) { { Gemm g{(const bf16_t*)(ws + WS_ATTM), (const bf16_t*)(ws + WS_WATTO), MTOK, 1024, 512, 512, 512}; EpiArgs ea{}; ea.gate = (const bf16_t*)(ws + WS_PGATE); ea.p0 = A->in[I_BGATE]; ea.t1 = (float*)(ws + WS_T1); gemm_call<EP_ATTOUT>(WV, lds, g, ea); }
                   { Gemm g{(const bf16_t*)(ws + WS_RWO), (const bf16_t*)(ws + WS_WRWO), MTOK, 1024, 1024, 1024, 1024}; EpiArgs ea{}; ea.gate = (const bf16_t*)(ws + WS_PGATE); ea.p0 = A->in[I_BGATE]; ea.t1 = (float*)(ws + WS_T1); ea.o0 = (bf16_t*)(ws + WS_MIX); gemm_call<EP_RWOUT>(WV, lds, g, ea); } } PH_END
    PH_BEGIN(14) { Gemm g{(const bf16_t*)(ws + WS_MIX), (const bf16_t*)(ws + WS_WO), MTOK, 1024, 1024, 1024, 1024}; EpiArgs ea{}; ea.p0 = ada + 2048; ea.row0g = 0; ea.base = A->in[I_X]; ea.outf = A->out; gemm_call<EP_RESID>(WV, lds, g, ea); } PH_END
    PH_BEGIN(15) p_ffn_weights(WV, A, lds);
                 norm_rows<true, true>(WV, A->out, A->in[I_N2W], ada + 3072, ada + 4096, ws + WS_H2, MTOK, 0); PH_END
    PH_BEGIN(16) { Gemm g{(const bf16_t*)(ws + WS_H2), (const bf16_t*)(ws + WS_WUP), MTOK, 5632, 1024, 1024, 1024}; EpiArgs ea{}; ea.o0 = (bf16_t*)(ws + WS_U); ea.ld0 = 5632; ea.ncol0 = 1 << 30; gemm_call<EP_BF16>(WV, lds, g, ea); } PH_END
#if !MK_ONE_LAUNCH
    PH_BEGIN(13) halo_phase(WV, A); PH_END
#endif
    PH_BEGIN(17) conv_phase(WV, A, bar, bst, MK_ONE_LAUNCH != 0); PH_END
    PH_BEGIN(18) { Gemm g{(const bf16_t*)(ws + WS_U), (const bf16_t*)(ws + WS_WDN), MTOK, 1024, DFF, 5632, DFF}; EpiArgs ea{}; ea.p0 = ada + 5120; ea.row0g = 0; ea.base = A->out; ea.outf = A->out; gemm_call<EP_RESID>(WV, lds, g, ea); } PH_END
    PH_BEGIN(19) norm_rows<false, false>(WV, A->out, A->in[I_NFW], nullptr, nullptr, A->out, MTOK, 0); PH_END
#undef PH_BEGIN
#undef PH_END
}

constexpr unsigned LIGHT_MASK = (1u << 0) | (1u << 1) | (1u << 3) | (1u << 7) | (1u << 8) | (1u << 11) | (1u << 13) | (1u << 15) | (1u << 17) | (1u << 19);
#if MK_ONE_LAUNCH
static const int kind_of_phase[N_PHASES] = {0, 1, 2, 3, 4, 5, 6, 7, 8, 9, 10, 11, 9, 10, 11, 12, 14, 15, 16, 17, 18, 19};
#else
static const int kind_of_phase[N_PHASES] = {0, 1, 2, 3, 4, 5, 6, 7, 8, 9, 10, 11, 9, 10, 11, 12, 14, 15, 16, 13, 17, 18, 19};
#endif
typedef void (*kfn_t)(Args);
static kfn_t kernel_for_kind(int k) {
#if MK_ONE_LAUNCH
    (void)k; return fwd_kernel<0xFFFFFu>;
#else
    switch (k) {
        case 2: return fwd_kernel<1u << 2>; case 4: return fwd_kernel<1u << 4>; case 5: return fwd_kernel<1u << 5>; case 6: return fwd_kernel<1u << 6>;
        case 9: return fwd_kernel<1u << 9>; case 10: return fwd_kernel<1u << 10>; case 12: return fwd_kernel<1u << 12>; case 13: return fwd_kernel<1u << 13>;
        case 14: return fwd_kernel<1u << 14>; case 16: return fwd_kernel<1u << 16>; case 18: return fwd_kernel<1u << 18>;
        default: return fwd_kernel<LIGHT_MASK>;
    }
#endif
}
extern "C" void kernel_launch(void* const* d_in, const int* in_sizes, int n_in, void* d_out, int out_size, void* d_ws, size_t ws_size, hipStream_t stream) {
    static int grid = 0;
    if (grid == 0) {
        if (n_in != 27 || out_size != MTOK * D || ws_size < WS_NEED) { fprintf(stderr, "kernel_launch: unexpected shapes (n_in %d out %d ws %zu, need %zu)\n", n_in, out_size, ws_size, (size_t)WS_NEED); grid = -1; return; }
        int dev = 0, cus = 0;
        if (hipGetDevice(&dev) != hipSuccess || hipDeviceGetAttribute(&cus, hipDeviceAttributeMultiprocessorCount, dev) != hipSuccess) cus = 256;
        for (int k = 0; k < 20; ++k)
            if (hipFuncSetAttribute((const void*)kernel_for_kind(k), hipFuncAttributeMaxDynamicSharedMemorySize, LDS_BYTES) != hipSuccess) { fprintf(stderr, "kernel_launch: hipFuncSetAttribute failed\n"); grid = -1; return; }
        (void)hipGetLastError();
        grid = cus > 0 ? cus : 256;
    }
    if (grid < 0) return;
    Args a{};
    for (int i = 0; i < 27; ++i) a.in[i] = (const float*)d_in[i];
    a.out = (float*)d_out; a.ws = (unsigned char*)d_ws;
#if MK_ONE_LAUNCH
    a.ph_lo = 0; a.ph_hi = N_PHASES;
    if (hipMemsetAsync((char*)d_ws + WS_BAR, 0, XCD_BAR_WORDS * sizeof(unsigned), stream) != hipSuccess) { fprintf(stderr, "kernel_launch: memset of barrier words failed\n"); return; }
    void* args[] = {&a};
    hipError_t e = hipLaunchCooperativeKernel((const void*)fwd_kernel<0xFFFFFu>, dim3(grid), dim3(NTHREADS), args, LDS_BYTES, stream);
    if (e != hipSuccess) fprintf(stderr, "kernel_launch: cooperative launch failed: %s (grid %d)\n", hipGetErrorString(e), grid);
#else
    for (int p = 0; p < N_PHASES; ++p) {
        a.ph_lo = p; a.ph_hi = p + 1;
        hipLaunchKernelGGL(kernel_for_kind(kind_of_phase[p]), dim3(grid), dim3(NTHREADS), LDS_BYTES, stream, a);
    }
#endif
}
```

```cpp
#include <hip/hip_runtime.h>
#include <hip/hip_cooperative_groups.h>
#include <cstdio>
#include <cstdint>
namespace cg = cooperative_groups;

#ifndef MK_ONE_LAUNCH
#define MK_ONE_LAUNCH 1
#endif

#define LAS __attribute__((address_space(3)))
typedef unsigned short bf16_t;
typedef short bf16x8 __attribute__((ext_vector_type(8)));
typedef float f32x4 __attribute__((ext_vector_type(4)));
typedef float f32x2 __attribute__((ext_vector_type(2)));
typedef unsigned u32x4 __attribute__((ext_vector_type(4)));
typedef unsigned u32x2 __attribute__((ext_vector_type(2)));
typedef LAS unsigned char* lds_t;

constexpr int SEQ = 4096, NB = 8, D = 1024, MTOK = NB * SEQ;
constexpr int NRW = 3584;
constexpr int NAG = 6656;
constexpr int DFF = 2816;
constexpr int CH = 16384;
constexpr int NTHREADS = 512;
constexpr int LDS_BYTES = 131072 + 16;
constexpr int N_PHASES = 8 + (4 + 3) + 2 + (MK_ONE_LAUNCH ? 5 : 6);

constexpr size_t MiB = 1048576;
constexpr size_t WS_WATTO = 0 * MiB, WS_WRWO = 1 * MiB, WS_WO = 3 * MiB, WS_WLORA = 5 * MiB, WS_ADA = 7 * MiB + 512 * 1024;
constexpr size_t WS_WINRW = 8 * MiB, WS_WINAG = 15 * MiB;
constexpr size_t WS_H1 = 45 * MiB, WS_Y = 45 * MiB, WS_PRW = 109 * MiB, WS_ALORA = 333 * MiB, WS_EA = 357 * MiB, WS_BS = 485 * MiB;
constexpr size_t WS_G = 357 * MiB, WS_RWO = 421 * MiB;
constexpr size_t WS_H1C = 28 * MiB, WS_PATT = 60 * MiB, WS_ATTO = 204 * MiB, WS_LSE = 8 * MiB, WS_PGATE = 252 * MiB, WS_ATTM = 380 * MiB;
constexpr size_t WS_T1 = 28 * MiB, WS_MIX = 156 * MiB;
constexpr size_t WS_WUP = 8 * MiB, WS_WDN = 19 * MiB, WS_H2 = 28 * MiB, WS_U = 92 * MiB, WS_HALO = 444 * MiB;
constexpr size_t WS_BAR = 503 * MiB;
constexpr size_t WS_NEED = 504 * MiB;

__device__ __forceinline__ float bf_lo(unsigned u) { return __uint_as_float(u << 16); }
__device__ __forceinline__ float bf_hi(unsigned u) { return __uint_as_float(u & 0xffff0000u); }
__device__ __forceinline__ float bf2f(bf16_t v) { return __uint_as_float(((unsigned)v) << 16); }
__device__ __forceinline__ unsigned pk_bf16(float lo, float hi) { unsigned r; asm volatile("v_cvt_pk_bf16_f32 %0, %1, %2" : "=v"(r) : "v"(lo), "v"(hi)); return r; }
__device__ __forceinline__ bf16_t f2bf(float f) { return (bf16_t)(pk_bf16(f, 0.f) & 0xffffu); }
__device__ __forceinline__ int lane_id_asm() { int l; asm volatile("v_mbcnt_lo_u32_b32 %0, -1, 0\n\tv_mbcnt_hi_u32_b32 %0, -1, %0" : "=v"(l)); return l; }
__device__ __forceinline__ int ltid_w(int w) { asm volatile("" : "+s"(w)); return w * 64 + lane_id_asm(); }
#define ltid() ltid_w(WV)
__device__ __forceinline__ float sigm(float x) { return __builtin_amdgcn_rcpf(1.0f + __expf(-x)); }
template <int CTRL> __device__ __forceinline__ float dppf(float x) { return __builtin_bit_cast(float, __builtin_amdgcn_mov_dpp(__builtin_bit_cast(int, x), CTRL, 0xf, 0xf, true)); }
__device__ __forceinline__ float allred16(float x) { x += dppf<0xB1>(x); x += dppf<0x4E>(x); x += dppf<0x141>(x); x += dppf<0x128>(x); return x; }

namespace pg8 {
constexpr int BM = 256, BK = 64, HALF = 128, HTB = HALF * BK * 2, STAGE_BYTES = 8 * HTB, NXCD = 8, WGM = 2;
__host__ __device__ __forceinline__ int lds_byte(int r, int c) { const int st = (r >> 4) * 2 + (c >> 5), rr = r & 15, cc = c & 31, ob = rr * 64 + cc * 2; return st * 1024 + (ob ^ (((ob >> 9) & 1) << 5)); }
__host__ __device__ __forceinline__ void stage_rc(int b, int& R, int& C) { const int st = b / 1024, sb = b % 1024, swz = sb ^ (((sb >> 9) & 1) << 5); R = (st >> 1) * 16 + swz / 64; C = (st & 1) * 32 + (swz % 64) / 2; }
__host__ __device__ __forceinline__ int perm32(int rho) { const int n = rho >> 4, i = rho & 15; return 8 * (i >> 2) + 4 * n + (i & 3); }
struct Unit { int pm, pn; };
struct Gemm { const bf16_t* A; const bf16_t* Bt; int M, N, K, lda, ldb; };
struct StaticOrder {
    int nM, nN, nwg, G, c;
    __device__ void init(int M, int N, int G_, int c_) { nM = M / BM; nN = N / BM; nwg = nM * nN; G = G_; c = c_; }
    __device__ bool next(int i, Unit& u) const {
        const long L = (long)i * G + c; if (L >= nwg) return false;
        int wgid = (int)L; { const int q = nwg / NXCD, r = nwg % NXCD, xcd = wgid % NXCD, off = wgid / NXCD; wgid = (xcd < r ? xcd * (q + 1) : r * (q + 1) + (xcd - r) * q) + off; }
        const int nig = WGM * nN, gid = wgid / nig, fm = gid * WGM, gsz = (nM - fm) < WGM ? (nM - fm) : WGM;
        u.pm = fm + ((wgid % nig) % gsz); u.pn = (wgid % nig) / gsz; return true;
    }
};

template <class Epi, bool ALIGN_EPI = true>
__device__ __forceinline__ void gemm_phase(const int WV, lds_t lds, const Gemm g, const StaticOrder& S, const Epi& E) {
    const int tid = ltid(), wid = __builtin_amdgcn_readfirstlane(tid >> 6), lane = tid & 63, wr = wid >> 2, wc = wid & 3, fr = lane & 15, fq = lane >> 4;
    const int K = g.K, nt = K / BK;
    unsigned voffA[2], voffB[2];
#pragma unroll
    for (int i = 0; i < 2; ++i) { int R, C; stage_rc(tid * 16 + i * 8192, R, C); const int Rb = Epi::PERM ? ((R & ~31) + perm32(R & 31)) : R;
        voffA[i] = (unsigned)(R * g.lda + C) * 2u; voffB[i] = (unsigned)(Rb * g.ldb + C) * 2u; }
    const size_t kstep = (size_t)(BK * 2);
    const size_t hstepA = (size_t)HALF * g.lda * 2, hstepB = (size_t)HALF * g.ldb * 2;
    const size_t tstepA = 2 * hstepA, tstepB = 2 * hstepB;
    const unsigned ldsw = (unsigned)wid * 1024u;
    const int aoff = lds_byte(wr * 64 + fr, fq * 8), boff = lds_byte(wc * 32 + fr, fq * 8);
#define PG8_SA(b, h) (((b) * 2 + (h)) * HTB)
#define PG8_SB(b, h) ((4 + (b) * 2 + (h)) * HTB)
#define PG8_STAGE(bufoff, gbase, voff) do { _Pragma("unroll") for (int _i = 0; _i < 2; ++_i) \
        __builtin_amdgcn_global_load_lds((const unsigned*)((const char*)(gbase) + (voff)[_i]), (LAS unsigned*)(lds + (bufoff) + ldsw + _i * 8192), 16, 0, 0); } while (0)
#define PG8_LDA(dst, b, h) do { _Pragma("unroll") for (int m = 0; m < 4; ++m) _Pragma("unroll") for (int k = 0; k < 2; ++k) dst[m][k] = *(const LAS bf16x8*)(lds + PG8_SA(b, h) + aoff + m * 2048 + k * 1024); } while (0)
#define PG8_LDB(dst, b, h) do { _Pragma("unroll") for (int n = 0; n < 2; ++n) _Pragma("unroll") for (int k = 0; k < 2; ++k) dst[n][k] = *(const LAS bf16x8*)(lds + PG8_SB(b, h) + boff + n * 2048 + k * 1024); } while (0)
#define PG8_MMA(ai, bj, At, Bt) do { __builtin_amdgcn_s_setprio(1); _Pragma("unroll") for (int m = 0; m < 4; ++m) _Pragma("unroll") for (int n = 0; n < 2; ++n) _Pragma("unroll") for (int k = 0; k < 2; ++k) \
        acc[ai][bj][m][n] = __builtin_amdgcn_mfma_f32_16x16x32_bf16(Bt[n][k], At[m][k], acc[ai][bj][m][n], 0, 0, 0); __builtin_amdgcn_s_setprio(0); } while (0)
#define PG8_WAIT_V(n) asm volatile("s_waitcnt vmcnt(" #n ")" ::: "memory")
#define PG8_WAIT_L(n) asm volatile("s_waitcnt lgkmcnt(" #n ")" ::: "memory")
#define PG8_BAR __builtin_amdgcn_s_barrier()
#define PG8_SCHED __builtin_amdgcn_sched_barrier(0)
    Unit cur, nxt; int ui = 0;
    if (!S.next(0, cur)) return;
    f32x4 acc[2][2][4][2];
#pragma unroll
    for (int a = 0; a < 2; ++a)
#pragma unroll
        for (int b = 0; b < 2; ++b)
#pragma unroll
            for (int m = 0; m < 4; ++m)
#pragma unroll
                for (int n = 0; n < 2; ++n) acc[a][b][m][n] = (f32x4){0.f, 0.f, 0.f, 0.f};
    bf16x8 At[4][2], B0[2][2], B1[2][2];
    const char* cA = (const char*)g.A + (size_t)cur.pm * tstepA; const char* cB = (const char*)g.Bt + (size_t)cur.pn * tstepB;
    PG8_STAGE(PG8_SB(0, 0), cB, voffB); PG8_STAGE(PG8_SB(0, 1), cB + hstepB, voffB); PG8_STAGE(PG8_SA(0, 0), cA, voffA); PG8_STAGE(PG8_SA(0, 1), cA + hstepA, voffA);
    if (wr == 1) PG8_BAR;
    PG8_WAIT_V(2); PG8_BAR;
    PG8_STAGE(PG8_SB(1, 0), cB + kstep, voffB); PG8_STAGE(PG8_SA(1, 0), cA + kstep, voffA); PG8_STAGE(PG8_SB(1, 1), cB + hstepB + kstep, voffB);
    PG8_WAIT_V(6); PG8_BAR;
    for (;;) {
        const bool has_next = S.next(ui + 1, nxt);
        const char* nA = has_next ? (const char*)g.A + (size_t)nxt.pm * tstepA : cA; const char* nB = has_next ? (const char*)g.Bt + (size_t)nxt.pn * tstepB : cB;
        for (int t = 0; t < nt; t += 2) {
            const bool last = (t == nt - 2);
            const char* a1 = cA + (size_t)(t + 1) * kstep;
            const char* a2 = last ? nA : cA + (size_t)(t + 2) * kstep; const char* b2 = last ? nB : cB + (size_t)(t + 2) * kstep;
            const char* a3 = a2 + kstep; const char* b3 = b2 + kstep;
            PG8_LDB(B0, 0, 0); PG8_LDB(B1, 0, 1); PG8_SCHED; PG8_LDA(At, 0, 0); PG8_STAGE(PG8_SA(1, 1), a1 + hstepA, voffA);
            PG8_WAIT_V(8); PG8_WAIT_L(0); PG8_BAR; PG8_MMA(0, 0, At, B0); PG8_MMA(0, 1, At, B1); PG8_BAR; PG8_SCHED;
            PG8_LDA(At, 0, 1); PG8_STAGE(PG8_SB(0, 0), b2, voffB); PG8_STAGE(PG8_SB(0, 1), b2 + hstepB, voffB); PG8_STAGE(PG8_SA(0, 0), a2, voffA);
            PG8_WAIT_V(8); PG8_WAIT_L(0); PG8_BAR; PG8_MMA(1, 0, At, B0); PG8_MMA(1, 1, At, B1); PG8_BAR; PG8_SCHED;
            PG8_LDB(B0, 1, 0); PG8_LDB(B1, 1, 1); PG8_SCHED; PG8_LDA(At, 1, 0); PG8_STAGE(PG8_SA(0, 1), a2 + hstepA, voffA);
            PG8_WAIT_V(8); PG8_WAIT_L(0); PG8_BAR; PG8_MMA(0, 0, At, B0); PG8_MMA(0, 1, At, B1); PG8_BAR; PG8_SCHED;
            PG8_LDA(At, 1, 1); PG8_STAGE(PG8_SB(1, 0), b3, voffB); PG8_STAGE(PG8_SB(1, 1), b3 + hstepB, voffB); PG8_STAGE(PG8_SA(1, 0), a3, voffA);
            PG8_WAIT_V(8); PG8_WAIT_L(0); PG8_BAR; PG8_MMA(1, 0, At, B0); PG8_MMA(1, 1, At, B1); PG8_BAR; PG8_SCHED;
        }
        if constexpr (ALIGN_EPI) { if (wr == 0) PG8_BAR; }
        E(acc, cur, wr, wc, fr, fq);
        if (!has_next) break;
#pragma unroll
        for (int a = 0; a < 2; ++a)
#pragma unroll
            for (int b = 0; b < 2; ++b)
#pragma unroll
                for (int m = 0; m < 4; ++m)
#pragma unroll
                    for (int n = 0; n < 2; ++n) acc[a][b][m][n] = (f32x4){0.f, 0.f, 0.f, 0.f};
        cur = nxt; cA = nA; cB = nB; ++ui;
        if constexpr (ALIGN_EPI) { if (wr == 1) PG8_BAR; }
    }
    PG8_WAIT_V(0);
    if constexpr (!ALIGN_EPI) { if (wr == 0) PG8_BAR; }
    PG8_BAR;
#undef PG8_SA
#undef PG8_SB
#undef PG8_STAGE
#undef PG8_LDA
#undef PG8_LDB
#undef PG8_MMA
#undef PG8_WAIT_V
#undef PG8_WAIT_L
#undef PG8_BAR
#undef PG8_SCHED
}

enum { EP_BF16 = 0, EP_EA = 1, EP_ATTOUT = 2, EP_RWOUT = 3, EP_RESID = 4, EP_EAH = 5 };
struct EpiArgs {
    bf16_t* o0; bf16_t* o1; int ld0, ld1, ncol0, row0g;
    const float* p0; const float* p1;
    const bf16_t* gate; float* t1; const float* base; float* outf;
};
template <int MODE> struct Epi {
    static constexpr bool PERM = (MODE == EP_BF16 || MODE == EP_EA || MODE == EP_RWOUT || MODE == EP_EAH);
    EpiArgs a;
    __device__ __forceinline__ void operator()(const f32x4 (&acc)[2][2][4][2], const Unit& u, int wr, int wc, int fr, int fq) const {
        { const int l_ = lane_id_asm(); fr = l_ & 15; fq = l_ >> 4; }
        const int row0 = u.pm * BM + wr * 64 + fr;
        if constexpr (MODE == EP_BF16) {
            int colt = u.pn * BM; bf16_t* base = a.o0; int ld = a.ld0;
            if (colt >= a.ncol0) { base = a.o1; ld = a.ld1; colt -= a.ncol0; }
            const int col0 = colt + wc * 32 + 8 * fq;
#pragma unroll
            for (int ai = 0; ai < 2; ++ai)
#pragma unroll
                for (int m = 0; m < 4; ++m) { bf16_t* rowp = base + (size_t)(row0 + ai * HALF + m * 16) * ld + col0;
#pragma unroll
                    for (int bj = 0; bj < 2; ++bj) { const f32x4 v0 = acc[ai][bj][m][0], v1 = acc[ai][bj][m][1];
                        u32x4 w; w.x = pk_bf16(v0[0], v0[1]); w.y = pk_bf16(v0[2], v0[3]); w.z = pk_bf16(v1[0], v1[1]); w.w = pk_bf16(v1[2], v1[3]);
                        *(u32x4*)(rowp + bj * HALF) = w; }
                    asm volatile("" ::: "memory"); }
        } else if constexpr (MODE == EP_EAH) {
            const int frl = fr, fql = fq;
            const int rb = u.pm * BM, bb = rb >> 12, t0 = (rb & 4095) + wr * 64 + frl;
            const int c0 = u.pn * BM + wc * 32 + 8 * fql, c1 = c0 + HALF;
            const unsigned of0 = (unsigned)(bb * 16 + ((c0 >> 6) & 15)) * 524288u + (unsigned)t0 * 128u + (unsigned)((c0 >> 10) * 64 + (c0 & 63));
            const unsigned of1 = (unsigned)(bb * 16 + ((c1 >> 6) & 15)) * 524288u + (unsigned)t0 * 128u + (unsigned)((c1 >> 10) * 64 + (c1 & 63));
#pragma unroll
            for (int ai = 0; ai < 2; ++ai)
#pragma unroll
                for (int m = 0; m < 4; ++m) {
#pragma unroll
                    for (int bj = 0; bj < 2; ++bj) { const f32x4 v0 = acc[ai][bj][m][0], v1 = acc[ai][bj][m][1];
                        u32x4 w; w.x = pk_bf16(v0[0], v0[1]); w.y = pk_bf16(v0[2], v0[3]); w.z = pk_bf16(v1[0], v1[1]); w.w = pk_bf16(v1[2], v1[3]);
                        *(u32x4*)(a.o0 + ((bj ? of1 : of0) + (unsigned)((ai * HALF + m * 16) * 128))) = w; }
                    asm volatile("" ::: "memory"); }
        } else if constexpr (MODE == EP_EA) {
            const int col0 = u.pn * BM + wc * 32 + 8 * fq;
            const bool isw = (u.pn < 4);
            const float* bias = isw ? a.p0 : (a.p1 - 1024);
            const float scl = isw ? 0.60653066f : 1.0f;
#pragma unroll
            for (int ai = 0; ai < 2; ++ai)
#pragma unroll
                for (int m = 0; m < 4; ++m) { bf16_t* rowp = a.o0 + (size_t)(row0 + ai * HALF + m * 16) * a.ld0 + col0;
#pragma unroll
                    for (int bj = 0; bj < 2; ++bj) { const f32x4 bv0 = *(const f32x4*)(bias + col0 + bj * HALF), bv1 = *(const f32x4*)(bias + col0 + bj * HALF + 4);
                        f32x4 v0 = acc[ai][bj][m][0] + bv0, v1 = acc[ai][bj][m][1] + bv1;
#pragma unroll
                        for (int j = 0; j < 4; ++j) { v0[j] = scl * sigm(v0[j]); v1[j] = scl * sigm(v1[j]); }
                        u32x4 w; w.x = pk_bf16(v0[0], v0[1]); w.y = pk_bf16(v0[2], v0[3]); w.z = pk_bf16(v1[0], v1[1]); w.w = pk_bf16(v1[2], v1[3]);
                        *(u32x4*)(rowp + bj * HALF) = w; }
                    asm volatile("" ::: "memory"); }
        } else if constexpr (MODE == EP_ATTOUT) {
            const int col0 = u.pn * BM + wc * 32 + 4 * fq;
#pragma unroll
            for (int ai = 0; ai < 2; ++ai)
#pragma unroll
                for (int m = 0; m < 4; ++m) { const size_t r = (size_t)(row0 + ai * HALF + m * 16);
#pragma unroll
                    for (int bj = 0; bj < 2; ++bj)
#pragma unroll
                        for (int n = 0; n < 2; ++n) { const int c = col0 + bj * HALF + n * 16;
                            const u32x2 gq = *(const u32x2*)(a.gate + r * 2048 + c); const f32x4 bg = *(const f32x4*)(a.p0 + c);
                            const f32x4 v = acc[ai][bj][m][n]; f32x4 o;
                            o[0] = sigm(bf_lo(gq.x) + bg[0]) * v[0]; o[1] = sigm(bf_hi(gq.x) + bg[1]) * v[1]; o[2] = sigm(bf_lo(gq.y) + bg[2]) * v[2]; o[3] = sigm(bf_hi(gq.y) + bg[3]) * v[3];
                            *(f32x4*)(a.t1 + r * 1024 + c) = o; }
                    asm volatile("" ::: "memory"); }
        } else if constexpr (MODE == EP_RWOUT) {
            const int col0 = u.pn * BM + wc * 32 + 8 * fq;
#pragma unroll
            for (int ai = 0; ai < 2; ++ai)
#pragma unroll
                for (int m = 0; m < 4; ++m) { const size_t r = (size_t)(row0 + ai * HALF + m * 16);
#pragma unroll
                    for (int bj = 0; bj < 2; ++bj) { const int c = col0 + bj * HALF;
                        const u32x4 gq = *(const u32x4*)(a.gate + r * 2048 + 1024 + c);
                        const f32x4 b0 = *(const f32x4*)(a.p0 + 1024 + c), b1 = *(const f32x4*)(a.p0 + 1024 + c + 4);
                        const f32x4 t0 = *(const f32x4*)(a.t1 + r * 1024 + c), t1v = *(const f32x4*)(a.t1 + r * 1024 + c + 4);
                        const f32x4 v0 = acc[ai][bj][m][0], v1 = acc[ai][bj][m][1]; f32x4 o0, o1;
                        o0[0] = t0[0] + sigm(bf_lo(gq.x) + b0[0]) * v0[0]; o0[1] = t0[1] + sigm(bf_hi(gq.x) + b0[1]) * v0[1];
                        o0[2] = t0[2] + sigm(bf_lo(gq.y) + b0[2]) * v0[2]; o0[3] = t0[3] + sigm(bf_hi(gq.y) + b0[3]) * v0[3];
                        o1[0] = t1v[0] + sigm(bf_lo(gq.z) + b1[0]) * v1[0]; o1[1] = t1v[1] + sigm(bf_hi(gq.z) + b1[1]) * v1[1];
                        o1[2] = t1v[2] + sigm(bf_lo(gq.w) + b1[2]) * v1[2]; o1[3] = t1v[3] + sigm(bf_hi(gq.w) + b1[3]) * v1[3];
                        u32x4 w; w.x = pk_bf16(o0[0], o0[1]); w.y = pk_bf16(o0[2], o0[3]); w.z = pk_bf16(o1[0], o1[1]); w.w = pk_bf16(o1[2], o1[3]);
                        *(u32x4*)(a.o0 + r * 1024 + c) = w; }
                    asm volatile("" ::: "memory"); }
        } else {
            const int col0 = u.pn * BM + wc * 32 + 4 * fq;
            const int bidx = (a.row0g + u.pm * BM) >> 12;
            const float* gp = a.p0 + (size_t)bidx * 6144 + col0;
#pragma unroll
            for (int ai = 0; ai < 2; ++ai)
#pragma unroll
                for (int m = 0; m < 4; ++m) { const size_t off = (size_t)(row0 + ai * HALF + m * 16) * 1024 + col0;
#pragma unroll
                    for (int bj = 0; bj < 2; ++bj)
#pragma unroll
                        for (int n = 0; n < 2; ++n) { const f32x4 bs = *(const f32x4*)(a.base + off + bj * HALF + n * 16); const f32x4 gv = *(const f32x4*)(gp + bj * HALF + n * 16);
                            *(f32x4*)(a.outf + off + bj * HALF + n * 16) = bs + gv * acc[ai][bj][m][n]; }
                    asm volatile("" ::: "memory"); }
        }
    }
};
}

#define XB_TMO      128
#define XB_XCNT(j)  (256  + 64 * (j))
#define XB_XSUB(j)  (1280 + 64 * (j))
#define XB_XGEN(j)  (2304 + 64 * (j))
#define XB_TOP      3328
#define XB_TOPGEN   3392
#define XCD_BAR_WORDS 3456
#define XB_SPIN_CAP (1u << 20)
__device__ __forceinline__ unsigned xb_ld(unsigned* p)              { return __hip_atomic_load(p, __ATOMIC_RELAXED, __HIP_MEMORY_SCOPE_AGENT); }
__device__ __forceinline__ unsigned xb_add(unsigned* p, unsigned v) { return __hip_atomic_fetch_add(p, v, __ATOMIC_RELAXED, __HIP_MEMORY_SCOPE_AGENT); }
__device__ __forceinline__ unsigned xb_xcc_id() { return (unsigned)__builtin_amdgcn_s_getreg((3 << 11) | 20) & 0xFu; }
#define XB_SPIN(cond, bar) do { unsigned _sp = 0; while (cond) { __builtin_amdgcn_s_sleep(1); \
    if ((++_sp & 255u) == 0u) { if (xb_ld(&(bar)[XB_TMO])) break; if (_sp > XB_SPIN_CAP) { atomicAdd(&(bar)[XB_TMO], 1u); break; } } } } while (0)
__device__ __forceinline__ void xcd_barrier_complete(unsigned* bar, unsigned x, unsigned& nloc, unsigned& nx) {
    const unsigned G = gridDim.x; unsigned sum, cnt, mine, sp = 0u;
    for (;;) {
        sum = 0u; cnt = 0u; mine = 0u;
#pragma unroll
        for (unsigned j = 0; j < 16; ++j) { const unsigned c = xb_ld(&bar[XB_XCNT(j)]); sum += c; cnt += (c > 0u) ? 1u : 0u; mine = (j == x) ? c : mine; }
        if (sum == G) break;
        __builtin_amdgcn_s_sleep(1);
        if ((++sp & 255u) == 0u) { if (xb_ld(&bar[XB_TMO])) break; if (sp > XB_SPIN_CAP) { atomicAdd(&bar[XB_TMO], 1u); break; } }
    }
    nloc = mine > 0u ? mine : 1u; nx = cnt > 0u ? cnt : 1u;
}
__device__ __forceinline__ void xcd_barrier(const int WV, unsigned* bar, volatile LAS unsigned* st) {
    asm volatile("s_waitcnt vmcnt(0)" ::: "memory");
    __syncthreads();
    if (ltid() == 0) {
        const unsigned x = xb_xcc_id();
        __builtin_amdgcn_s_waitcnt(0);
        unsigned nloc = st[0], nx = st[1];
        if (nloc == 0u) { xcd_barrier_complete(bar, x, nloc, nx); st[0] = nloc; st[1] = nx; }
        const unsigned old = xb_add(&bar[XB_XSUB(x)], 1u);
        const unsigned gen = old / nloc;
        if (old + 1u == (gen + 1u) * nloc) {
            __builtin_amdgcn_fence(__ATOMIC_RELEASE, "agent");
            asm volatile("s_waitcnt vmcnt(0)" ::: "memory");
            const unsigned og = xb_add(&bar[XB_TOP], 1u);
            const unsigned tg = og / nx;
            if (og + 1u == (tg + 1u) * nx) xb_add(&bar[XB_TOPGEN], 1u);
            else XB_SPIN(xb_ld(&bar[XB_TOPGEN]) == tg, bar);
            __builtin_amdgcn_fence(__ATOMIC_ACQUIRE, "agent");
            xb_add(&bar[XB_XGEN(x)], 1u);
            asm volatile("s_waitcnt vmcnt(0)" ::: "memory");
        } else {
            XB_SPIN(xb_ld(&bar[XB_XGEN(x)]) == gen, bar);
            __builtin_amdgcn_fence(__ATOMIC_ACQUIRE, "agent");
            asm volatile("s_waitcnt vmcnt(0)" ::: "memory");
        }
    }
    __syncthreads();
}

struct Args { const float* in[27]; float* out; unsigned char* ws; int ph_lo, ph_hi; };
typedef const __attribute__((address_space(4))) Args* kargs_t;
__device__ __forceinline__ kargs_t launder_args(kargs_t p) { asm volatile("" : "+s"(p)); return p; }
enum { I_X = 0, I_C, I_WADA, I_BADA, I_N1W, I_WIN, I_BGATE, I_MU, I_W0, I_W2, I_A0, I_A2, I_G2, I_KK, I_KA, I_RK, I_LNW, I_LNB, I_WATTO, I_WRWO, I_WO, I_N2W, I_WUP, I_CONVW, I_CONVB, I_WDN, I_NFW };

__device__ __forceinline__ void conv_job(const int WV, const float* src, int ldn, int c0, int K, bf16_t* dst, int ldk, int r0, int nrows, lds_t lds) {
    LAS float* tile = (LAS float*)lds;
    const int tid = ltid(), nkt = K / 64, ntiles = (nrows / 32) * nkt;
    const int kl = tid >> 3, n4 = (tid & 7) * 4, nl = tid >> 4, k4 = (tid & 15) * 4;
    int t = blockIdx.x; f32x4 vn = (f32x4){0.f, 0.f, 0.f, 0.f};
    if (t < ntiles) vn = *(const f32x4*)(src + (size_t)((t % nkt) * 64 + kl) * ldn + c0 + (t / nkt) * 32 + n4);
    for (; t < ntiles; t += gridDim.x) {
        const int n0 = (t / nkt) * 32, k0 = (t % nkt) * 64; const f32x4 v = vn;
        const int tn = t + gridDim.x;
        if (tn < ntiles) vn = *(const f32x4*)(src + (size_t)((tn % nkt) * 64 + kl) * ldn + c0 + (tn / nkt) * 32 + n4);
        tile[kl * 33 + n4 + 0] = v[0]; tile[kl * 33 + n4 + 1] = v[1]; tile[kl * 33 + n4 + 2] = v[2]; tile[kl * 33 + n4 + 3] = v[3];
        __syncthreads();
        { u32x2 w; w.x = pk_bf16(tile[(k4 + 0) * 33 + nl], tile[(k4 + 1) * 33 + nl]); w.y = pk_bf16(tile[(k4 + 2) * 33 + nl], tile[(k4 + 3) * 33 + nl]);
          *(u32x2*)(dst + (size_t)(r0 + n0 + nl) * ldk + k0 + k4) = w; }
        __syncthreads();
    }
}
__device__ __forceinline__ void p0_weights(const int WV, kargs_t A, lds_t lds) {
    unsigned char* ws = A->ws; const int tid = ltid(), G = gridDim.x; const size_t gtid = (size_t)blockIdx.x * NTHREADS + tid, gsz = (size_t)G * NTHREADS;
    conv_job(WV, A->in[I_WIN], 10016, 4608, 1024, (bf16_t*)(ws + WS_WINRW), 1024, 0, 3360, lds);
    conv_job(WV, A->in[I_WIN], 10016, 0, 1024, (bf16_t*)(ws + WS_WINAG), 1024, 0, 4608, lds);
    conv_job(WV, A->in[I_WIN], 10016, 7968, 1024, (bf16_t*)(ws + WS_WINAG), 1024, 4608, 2048, lds);
    conv_job(WV, A->in[I_WATTO], 1024, 0, 512, (bf16_t*)(ws + WS_WATTO), 512, 0, 1024, lds);
    conv_job(WV, A->in[I_WRWO], 1024, 0, 1024, (bf16_t*)(ws + WS_WRWO), 1024, 0, 1024, lds);
    conv_job(WV, A->in[I_WO], 1024, 0, 1024, (bf16_t*)(ws + WS_WO), 1024, 0, 1024, lds);
    { unsigned* z = (unsigned*)(ws + WS_WINRW + (size_t)3360 * 1024 * 2); for (size_t i = gtid; i < (size_t)224 * 512; i += gsz) z[i] = 0u; }
    { bf16_t* wl = (bf16_t*)(ws + WS_WLORA); const float* w2 = A->in[I_W2]; const float* a2 = A->in[I_A2]; const float* g2 = A->in[I_G2];
      for (size_t i = gtid; i < (size_t)384 * 3072; i += gsz) { const int k = (int)(i / 3072), n = (int)(i % 3072), seg = n >> 10, nn = n & 1023; float v = 0.f;
          if (seg == 0) { if (k < 64) v = w2[k * 1024 + nn]; } else if (seg == 1) { if (k >= 64 && k < 128) v = a2[(k - 64) * 1024 + nn]; } else { if (k >= 128 && k < 288) v = g2[(k - 128) * 1024 + nn]; }
          wl[(size_t)n * 384 + k] = f2bf(v); } }
    { float* ada = (float*)(ws + WS_ADA); const float* cc = A->in[I_C]; const float* wa = A->in[I_WADA]; const float* ba = A->in[I_BADA]; LAS float* red = (LAS float*)lds;
      for (int item = blockIdx.x; item < 192; item += G) {
          const int cl = tid & 31, ks = tid >> 5, col = item * 32 + cl; float ac[8];
#pragma unroll
          for (int b = 0; b < 8; ++b) ac[b] = 0.f;
          for (int k = ks * 64; k < ks * 64 + 64; ++k) { const float w = wa[(size_t)k * 6144 + col];
#pragma unroll
              for (int b = 0; b < 8; ++b) ac[b] = fmaf(cc[b * 1024 + k], w, ac[b]); }
#pragma unroll
          for (int b = 0; b < 8; ++b) red[(ks * 8 + b) * 32 + cl] = ac[b];
          __syncthreads();
          if (tid < 256) { const int b = tid >> 5; float s = 0.f;
#pragma unroll
              for (int q = 0; q < 16; ++q) s += red[(q * 8 + b) * 32 + cl];
              ada[b * 6144 + col] = s + ba[col]; }
          __syncthreads();
      } }
}

__device__ __forceinline__ void p_ffn_weights(const int WV, kargs_t A, lds_t lds) {
    unsigned char* ws = A->ws;
    conv_job(WV, A->in[I_WUP], 5632, 0, 1024, (bf16_t*)(ws + WS_WUP), 1024, 0, 5632, lds);
    conv_job(WV, A->in[I_WDN], 1024, 0, 2816, (bf16_t*)(ws + WS_WDN), 2816, 0, 1024, lds);
}
template <bool ADA, bool OUTBF>
__device__ __forceinline__ void norm_rows(const int WV, const float* src, const float* w, const float* ada_sh, const float* ada_sc, void* dst, int nrows, int row0g) {
    const int tid_ = ltid(); const int lane = tid_ & 63, wid = tid_ >> 6;
    const int nw = gridDim.x * 8, gw = blockIdx.x * 8 + wid;
    const int per = (nrows + nw - 1) / nw, r_begin = gw * per, r_end = (r_begin + per < nrows) ? r_begin + per : nrows;
    f32x4 cw[4], cs[4], vn[4]; int cb = -1;
    if (r_begin < r_end) {
#pragma unroll
        for (int i = 0; i < 4; ++i) vn[i] = *(const f32x4*)(src + (size_t)r_begin * 1024 + 4 * (lane + 64 * i)); }
    for (int r = r_begin; r < r_end; ++r) {
        const int b = (row0g + r) >> 12;
        if (b != cb) { cb = b;
#pragma unroll
            for (int i = 0; i < 4; ++i) { const int c = 4 * (lane + 64 * i); cw[i] = *(const f32x4*)(w + c);
                if constexpr (ADA) { const f32x4 sc = *(const f32x4*)(ada_sc + (size_t)b * 6144 + c); cw[i] = cw[i] * (sc + 1.0f); cs[i] = *(const f32x4*)(ada_sh + (size_t)b * 6144 + c); } } }
        f32x4 v[4]; float ss = 0.f;
#pragma unroll
        for (int i = 0; i < 4; ++i) v[i] = vn[i];
        if (r + 1 < r_end) { const float* pn = src + (size_t)(r + 1) * 1024;
#pragma unroll
            for (int i = 0; i < 4; ++i) vn[i] = *(const f32x4*)(pn + 4 * (lane + 64 * i)); }
#pragma unroll
        for (int i = 0; i < 4; ++i) ss += v[i][0] * v[i][0] + v[i][1] * v[i][1] + v[i][2] * v[i][2] + v[i][3] * v[i][3];
#pragma unroll
        for (int o = 32; o >= 1; o >>= 1) ss += __shfl_xor(ss, o);
        const float rs = rsqrtf(ss * (1.0f / 1024.0f) + 1e-6f);
#pragma unroll
        for (int i = 0; i < 4; ++i) { const int c = 4 * (lane + 64 * i); f32x4 y = v[i] * rs * cw[i];
            if constexpr (ADA) y = y + cs[i];
            if constexpr (OUTBF) { u32x2 o; o.x = pk_bf16(y[0], y[1]); o.y = pk_bf16(y[2], y[3]); *(u32x2*)((bf16_t*)dst + (size_t)r * 1024 + c) = o; }
            else *(f32x4*)((float*)dst + (size_t)r * 1024 + c) = y; }
    }
}

__device__ __forceinline__ void lora_prep(const int WV, kargs_t A) {
    const bf16_t* prw = (const bf16_t*)(A->ws + WS_PRW); bf16_t* al = (bf16_t*)(A->ws + WS_ALORA); const float* mu = A->in[I_MU] + 3072;
    const size_t gtid = (size_t)blockIdx.x * NTHREADS + ltid(), gsz = (size_t)gridDim.x * NTHREADS;
    for (size_t it = gtid; it < (size_t)MTOK * 48; it += gsz) {
        const int row = (int)(it / 48), ch = (int)(it % 48); u32x4 o = (u32x4){0u, 0u, 0u, 0u};
        if (ch < 36) {
            const bf16_t* p = prw + (size_t)row * NRW + 3072 + ch * 8;
            const u32x4 cu = *(const u32x4*)p; u32x4 pv = (u32x4){0u, 0u, 0u, 0u}; if ((row & 4095) != 0) pv = *(const u32x4*)(p - NRW);
            const f32x4 m0 = *(const f32x4*)(mu + ch * 8), m1 = *(const f32x4*)(mu + ch * 8 + 4);
            float z[8], zp[8];
            z[0] = bf_lo(cu.x); z[1] = bf_hi(cu.x); z[2] = bf_lo(cu.y); z[3] = bf_hi(cu.y); z[4] = bf_lo(cu.z); z[5] = bf_hi(cu.z); z[6] = bf_lo(cu.w); z[7] = bf_hi(cu.w);
            zp[0] = bf_lo(pv.x); zp[1] = bf_hi(pv.x); zp[2] = bf_lo(pv.y); zp[3] = bf_hi(pv.y); zp[4] = bf_lo(pv.z); zp[5] = bf_hi(pv.z); zp[6] = bf_lo(pv.w); zp[7] = bf_hi(pv.w);
#pragma unroll
            for (int j = 0; j < 8; ++j) { const float m = j < 4 ? m0[j & 3] : m1[j & 3]; float s = z[j] + (zp[j] - z[j]) * m;
                if (ch < 8) s = tanhf(s); else if (ch >= 16) s = sigm(s);
                z[j] = s; }
            o.x = pk_bf16(z[0], z[1]); o.y = pk_bf16(z[2], z[3]); o.z = pk_bf16(z[4], z[5]); o.w = pk_bf16(z[6], z[7]);
        }
        *(u32x4*)(al + (size_t)row * 384 + ch * 8) = o;
    }
}

__device__ __forceinline__ float allred8(float x) { x += dppf<0xB1>(x); x += dppf<0x4E>(x); x += dppf<0x141>(x); return x; }
__device__ __forceinline__ void scan_phase(const int WV, kargs_t A, lds_t lds) {
    const bf16_t* prw = (const bf16_t*)(A->ws + WS_PRW); const bf16_t* ea = (const bf16_t*)(A->ws + WS_EA);
    bf16_t* Y = (bf16_t*)(A->ws + WS_Y); float* BS = (float*)(A->ws + WS_BS);
    LAS float* L = (LAS float*)lds;
    LAS float* SY = L + 22528;
    const int tid = ltid(); const bool scanw = (WV < 4);
    const int ltd = tid & 255, r8 = ltd >> 3, k8 = ltd & 7;
    for (int item = blockIdx.x; item < 256; item += gridDim.x) {
        const int half = item & 1, h = (item >> 1) & 15, b = item >> 5;
        const int cr = h * 64 + 8 * k8, cv = h * 64 + half * 32 + 4 * k8;
        f32x4 cmur[2], cmuk[2], ckkv[2], ckav[2], crkv[2];
#pragma unroll
        for (int q = 0; q < 2; ++q) { cmur[q] = *(const f32x4*)(A->in[I_MU] + cr + 4 * q); cmuk[q] = *(const f32x4*)(A->in[I_MU] + 1024 + cr + 4 * q);
            ckkv[q] = *(const f32x4*)(A->in[I_KK] + cr + 4 * q); ckav[q] = *(const f32x4*)(A->in[I_KA] + cr + 4 * q); crkv[q] = *(const f32x4*)(A->in[I_RK] + cr + 4 * q); }
        const f32x4 cmuv = *(const f32x4*)(A->in[I_MU] + 2048 + cv);
        auto produce = [&](const int cc, const int bufi) {
            const int t = cc * 32 + r8; const size_t row = (size_t)b * SEQ + t; const bf16_t* pr = prw + row * NRW; const bf16_t* pp = (t > 0) ? pr - NRW : pr;
            const u32x4 ur = *(const u32x4*)(pr + cr), uk = *(const u32x4*)(pr + 1024 + cr); u32x4 urp = *(const u32x4*)(pp + cr), ukp = *(const u32x4*)(pp + 1024 + cr);
            const u32x2 uv = *(const u32x2*)(pr + 2048 + cv); u32x2 uvp = *(const u32x2*)(pp + 2048 + cv);
            const u32x4 ue = *(const u32x4*)(ea + row * 2048 + cr), ua = *(const u32x4*)(ea + row * 2048 + 1024 + cr);
            if (t == 0) { urp = (u32x4){0u, 0u, 0u, 0u}; ukp = (u32x4){0u, 0u, 0u, 0u}; uvp = (u32x2){0u, 0u}; }
            const float zr[8] = {bf_lo(ur.x), bf_hi(ur.x), bf_lo(ur.y), bf_hi(ur.y), bf_lo(ur.z), bf_hi(ur.z), bf_lo(ur.w), bf_hi(ur.w)};
            const float zrp[8] = {bf_lo(urp.x), bf_hi(urp.x), bf_lo(urp.y), bf_hi(urp.y), bf_lo(urp.z), bf_hi(urp.z), bf_lo(urp.w), bf_hi(urp.w)};
            const float zk[8] = {bf_lo(uk.x), bf_hi(uk.x), bf_lo(uk.y), bf_hi(uk.y), bf_lo(uk.z), bf_hi(uk.z), bf_lo(uk.w), bf_hi(uk.w)};
            const float zkp[8] = {bf_lo(ukp.x), bf_hi(ukp.x), bf_lo(ukp.y), bf_hi(ukp.y), bf_lo(ukp.z), bf_hi(ukp.z), bf_lo(ukp.w), bf_hi(ukp.w)};
            const float ze[8] = {bf_lo(ue.x), bf_hi(ue.x), bf_lo(ue.y), bf_hi(ue.y), bf_lo(ue.z), bf_hi(ue.z), bf_lo(ue.w), bf_hi(ue.w)};
            const float za[8] = {bf_lo(ua.x), bf_hi(ua.x), bf_lo(ua.y), bf_hi(ua.y), bf_lo(ua.z), bf_hi(ua.z), bf_lo(ua.w), bf_hi(ua.w)};
            float r_[8], k_[8], e_[8], a_[8], kk_[8]; float n2 = 0.f;
#pragma unroll
            for (int i = 0; i < 8; ++i) {
                r_[i] = zr[i] + (zrp[i] - zr[i]) * cmur[i >> 2][i & 3]; k_[i] = zk[i] + (zkp[i] - zk[i]) * cmuk[i >> 2][i & 3];
                e_[i] = ze[i]; a_[i] = za[i];
                kk_[i] = k_[i] * ckkv[i >> 2][i & 3]; n2 = fmaf(kk_[i], kk_[i], n2); }
            n2 = allred8(n2); const float inv = __builtin_amdgcn_rcpf(fmaxf(__builtin_amdgcn_sqrtf(n2), 1e-12f));
            float o_r[8], o_w[8], o_k[8], o_a[8], o_b[8]; float bsum = 0.f;
#pragma unroll
            for (int i = 0; i < 8; ++i) { const float kn = kk_[i] * inv; const float km = k_[i] * (1.0f + (a_[i] - 1.0f) * ckav[i >> 2][i & 3]);
                o_r[i] = r_[i]; o_w[i] = __expf(-e_[i]); o_k[i] = km; o_a[i] = -kn; o_b[i] = kn * a_[i]; bsum = fmaf(r_[i] * km, crkv[i >> 2][i & 3], bsum); }
            bsum = allred8(bsum);
            LAS float* Bf = L + bufi * 11264 + r8 * 64 + 8 * k8;
#pragma unroll
            for (int q = 0; q < 2; ++q) {
                *(LAS f32x4*)(Bf + 4 * q) = (f32x4){o_r[4 * q], o_r[4 * q + 1], o_r[4 * q + 2], o_r[4 * q + 3]};
                *(LAS f32x4*)(Bf + 2048 + 4 * q) = (f32x4){o_w[4 * q], o_w[4 * q + 1], o_w[4 * q + 2], o_w[4 * q + 3]};
                *(LAS f32x4*)(Bf + 4096 + 4 * q) = (f32x4){o_k[4 * q], o_k[4 * q + 1], o_k[4 * q + 2], o_k[4 * q + 3]};
                *(LAS f32x4*)(Bf + 6144 + 4 * q) = (f32x4){o_a[4 * q], o_a[4 * q + 1], o_a[4 * q + 2], o_a[4 * q + 3]};
                *(LAS f32x4*)(Bf + 8192 + 4 * q) = (f32x4){o_b[4 * q], o_b[4 * q + 1], o_b[4 * q + 2], o_b[4 * q + 3]}; }
            { const float v0 = bf_lo(uv.x), v1 = bf_hi(uv.x), v2 = bf_lo(uv.y), v3 = bf_hi(uv.y);
              *(LAS f32x4*)(L + bufi * 11264 + 10240 + r8 * 32 + 4 * k8) = (f32x4){v0 + (bf_lo(uvp.x) - v0) * cmuv[0], v1 + (bf_hi(uvp.x) - v1) * cmuv[1], v2 + (bf_lo(uvp.y) - v2) * cmuv[2], v3 + (bf_hi(uvp.y) - v3) * cmuv[3]}; }
            if (half == 0 && k8 == 0) BS[row * 16 + h] = bsum;
        };
        auto ystore = [&](const int cc) {
            const LAS float* syr = SY + (cc % 3) * 1024 + r8 * 32 + 4 * k8; const f32x4 yv = *(const LAS f32x4*)syr;
            u32x2 w; w.x = pk_bf16(yv[0], yv[1]); w.y = pk_bf16(yv[2], yv[3]);
            *(u32x2*)(Y + ((size_t)(b * 16 + h) * 4096 + cc * 32 + r8) * 64 + half * 32 + 4 * k8) = w;
        };
        __syncthreads();
        if (!scanw) produce(0, 0);
        __syncthreads();
        f32x2 S0 = {0.f, 0.f}, S1 = {0.f, 0.f}, S2 = {0.f, 0.f}, S3 = {0.f, 0.f};
        float yq = 0.f, yreg = 0.f;
        struct StepIn { f32x4 r0, r1, w0, w1, k0, k1, a0, a1, b0, b1; float v; };
#define SCAN_LDS(R, t) do { const unsigned ab_ = (unsigned)(size_t)(Bc + (t) * 64 + 8 * k8), av_ = (unsigned)(size_t)(Bc + (t) * 32 + r8); \
            asm volatile("ds_read_b128 %0, %11 offset:24576\n\tds_read_b128 %1, %11 offset:24592\n\tds_read_b128 %2, %11 offset:32768\n\tds_read_b128 %3, %11 offset:32784\n\t" \
                         "ds_read_b32 %10, %12 offset:40960\n\tds_read_b128 %4, %11 offset:16384\n\tds_read_b128 %5, %11 offset:16400\n\t" \
                         "ds_read_b128 %6, %11 offset:8192\n\tds_read_b128 %7, %11 offset:8208\n\tds_read_b128 %8, %11\n\tds_read_b128 %9, %11 offset:16" \
                         : "=&v"(R.a0), "=&v"(R.a1), "=&v"(R.b0), "=&v"(R.b1), "=&v"(R.k0), "=&v"(R.k1), "=&v"(R.w0), "=&v"(R.w1), "=&v"(R.r0), "=&v"(R.r1), "=&v"(R.v) : "v"(ab_), "v"(av_) : "memory"); } while (0)
#define SCAN_WAIT(R) asm volatile("s_waitcnt lgkmcnt(11)" : "+v"(R.a0), "+v"(R.a1), "+v"(R.b0), "+v"(R.b1), "+v"(R.k0), "+v"(R.k1), "+v"(R.w0), "+v"(R.w1), "+v"(R.r0), "+v"(R.r1), "+v"(R.v) :: "memory")
#define P2(v4, i) ((f32x2){v4[2 * (i)], v4[2 * (i) + 1]})
#define SCAN_STEP(R, t) do { \
            f32x2 pa = S0 * P2(R.a0, 0), pb = S1 * P2(R.a0, 1); pa = S2 * P2(R.a1, 0) + pa; pb = S3 * P2(R.a1, 1) + pb; \
            float sa = (pa.x + pb.x) + (pa.y + pb.y); float yy = yq; \
            sa += dppf<0xB1>(sa); yy += dppf<0xB1>(yy); sa += dppf<0x4E>(sa); yy += dppf<0x4E>(yy); sa += dppf<0x141>(sa); yy += dppf<0x141>(yy); \
            yreg = (k8 == (((t) + 7) & 7)) ? yy : yreg; \
            const f32x2 sa2 = {sa, sa}, vv2 = {R.v, R.v}; \
            f32x2 t0 = vv2 * P2(R.k0, 0), t1 = vv2 * P2(R.k0, 1), t2 = vv2 * P2(R.k1, 0), t3 = vv2 * P2(R.k1, 1); \
            t0 = sa2 * P2(R.b0, 0) + t0; t1 = sa2 * P2(R.b0, 1) + t1; t2 = sa2 * P2(R.b1, 0) + t2; t3 = sa2 * P2(R.b1, 1) + t3; \
            S0 = S0 * P2(R.w0, 0) + t0; S1 = S1 * P2(R.w0, 1) + t1; S2 = S2 * P2(R.w1, 0) + t2; S3 = S3 * P2(R.w1, 1) + t3; \
            f32x2 qa = S0 * P2(R.r0, 0); qa = S1 * P2(R.r0, 1) + qa; qa = S2 * P2(R.r1, 0) + qa; qa = S3 * P2(R.r1, 1) + qa; \
            yq = qa.x + qa.y; } while (0)
        for (int c = 0; c < 128; ++c) {
            if (scanw) {
                const LAS float* Bc = L + (c & 1) * 11264;
                LAS float* syc = SY + (c % 3) * 1024; LAS float* syp = SY + ((c + 2) % 3) * 1024;
                StepIn R0, R1;
                SCAN_LDS(R0, 0);
#pragma unroll 4
                for (int t = 0; t < 32; t += 2) {
                    SCAN_LDS(R1, t + 1); SCAN_WAIT(R0); SCAN_STEP(R0, t);
                    if ((t & 7) == 0) { if (t == 0) { if (c > 0) syp[(24 + k8) * 32 + r8] = yreg; } else syc[(t - 8 + k8) * 32 + r8] = yreg; }
                    SCAN_LDS(R0, (t + 2) & 31); SCAN_WAIT(R1); SCAN_STEP(R1, t + 1);
                }
                asm volatile("s_waitcnt lgkmcnt(0)" : "+v"(R0.a0), "+v"(R0.a1), "+v"(R0.b0), "+v"(R0.b1), "+v"(R0.k0), "+v"(R0.k1), "+v"(R0.w0), "+v"(R0.w1), "+v"(R0.r0), "+v"(R0.r1), "+v"(R0.v) :: "memory");
            } else {
                if (c >= 2) ystore(c - 2);
                if (c + 1 < 128) produce(c + 1, (c + 1) & 1);
            }
            __syncthreads();
        }
        if (scanw) { const float yy = allred8(yq); yreg = (k8 == 7) ? yy : yreg; SY[(127 % 3) * 1024 + (24 + k8) * 32 + r8] = yreg; }
        __syncthreads();
        if (!scanw) { ystore(126); ystore(127); }
#undef SCAN_LDS
#undef SCAN_STEP
#undef P2
    }
}

__device__ __forceinline__ void post_phase(const int WV, kargs_t A) {
    const bf16_t* prw = (const bf16_t*)(A->ws + WS_PRW); const bf16_t* Y = (const bf16_t*)(A->ws + WS_Y); const bf16_t* Gg = (const bf16_t*)(A->ws + WS_G);
    const float* BS = (const float*)(A->ws + WS_BS); bf16_t* RWO = (bf16_t*)(A->ws + WS_RWO);
    const size_t gtid = (size_t)blockIdx.x * NTHREADS + ltid(), gsz = (size_t)gridDim.x * NTHREADS;
    constexpr int RR = 64;
    for (size_t it = gtid; it < (size_t)(MTOK / RR) * 256; it += gsz) {
        const int cg = (int)(it & 255), h = cg >> 4, kq = cg & 15, c = 4 * cg; const size_t row0 = (it >> 8) * RR; const int b = (int)(row0 >> 12), t0 = (int)(row0 & 4095);
        const f32x4 muv = *(const f32x4*)(A->in[I_MU] + 2048 + c), lw = *(const f32x4*)(A->in[I_LNW] + c), lb = *(const f32x4*)(A->in[I_LNB] + c);
        const bf16_t* yp = Y + ((size_t)(b * 16 + h) * 4096 + t0) * 64 + 4 * kq;
        u32x2 vp = (u32x2){0u, 0u}; if (t0 != 0) vp = *(const u32x2*)(prw + (row0 - 1) * NRW + 2048 + c);
#pragma unroll 4
        for (int rr = 0; rr < RR; ++rr) {
            const size_t row = row0 + rr;
            const u32x2 yu = *(const u32x2*)(yp + (size_t)rr * 64); const u32x2 vu = *(const u32x2*)(prw + row * NRW + 2048 + c);
            const u32x2 gu = *(const u32x2*)(Gg + row * 1024 + c); const float bs = BS[row * 16 + h];
            float y[4] = {bf_lo(yu.x), bf_hi(yu.x), bf_lo(yu.y), bf_hi(yu.y)};
            const float mean = allred16((y[0] + y[1]) + (y[2] + y[3])) * (1.0f / 64.0f);
            float q = 0.f;
#pragma unroll
            for (int i = 0; i < 4; ++i) { y[i] -= mean; q = fmaf(y[i], y[i], q); }
            const float rstd = rsqrtf(allred16(q) * (1.0f / 64.0f) + 64e-5f);
            const float vc[4] = {bf_lo(vu.x), bf_hi(vu.x), bf_lo(vu.y), bf_hi(vu.y)}, vq[4] = {bf_lo(vp.x), bf_hi(vp.x), bf_lo(vp.y), bf_hi(vp.y)}, gg[4] = {bf_lo(gu.x), bf_hi(gu.x), bf_lo(gu.y), bf_hi(gu.y)};
            float o[4];
#pragma unroll
            for (int i = 0; i < 4; ++i) { const float v = vc[i] + (vq[i] - vc[i]) * muv[i]; o[i] = (y[i] * rstd * lw[i] + lb[i] + bs * v) * gg[i]; }
            u32x2 w; w.x = pk_bf16(o[0], o[1]); w.y = pk_bf16(o[2], o[3]); *(u32x2*)(RWO + row * 1024 + c) = w;
            vp = vu;
        }
    }
}

__device__ __forceinline__ void attn_phase(const int WV, kargs_t A, lds_t lds) {
    const bf16_t* PATT = (const bf16_t*)(A->ws + WS_PATT); bf16_t* ATTO = (bf16_t*)(A->ws + WS_ATTO); float* LSE = (float*)(A->ws + WS_LSE);
    lds_t Ks = lds; lds_t Vt = lds + 36864;
    const int tid = ltid(), wid = tid >> 6, lane = tid & 63, fr = lane & 15, fq = lane >> 4, T0 = wid & ~1;
    u32x4 pk_[4], pv_[4]; bf16x8 pq_[2];
#define ATT_DECODE(u) const int idx = (u) & 31, h = ((u) >> 5) & 7, gb = (u) >> 8, g = gb % 3, bl = gb / 3; \
        const int dl = (g == 0) ? 0 : (g == 1 ? 2 : 4); const int r = idx & ((1 << dl) - 1), n = idx >> dl; \
        const bf16_t* base = PATT + (size_t)(bl * SEQ) * 4608 + g * 1536 + h * 64;
#define ATT_LOAD(u) do { ATT_DECODE(u) \
        _Pragma("unroll") for (int i = 0; i < 4; ++i) { const int c = tid + 512 * i, key = c >> 3, part = c & 7; int j = 128 * n - 128 + key; j = j < 0 ? 0 : j; const size_t pos = ((size_t)j << dl) + r; \
            pk_[i] = *(const u32x4*)(base + pos * 4608 + 512 + part * 8); pv_[i] = *(const u32x4*)(base + pos * 4608 + 1024 + part * 8); } \
        { const int qi_ = 16 * wid + fr; const size_t pos = ((size_t)(128 * n + qi_) << dl) + r; pq_[0] = *(const bf16x8*)(base + pos * 4608 + fq * 8); pq_[1] = *(const bf16x8*)(base + pos * 4608 + 32 + fq * 8); } } while (0)
    if ((int)blockIdx.x < 3072) ATT_LOAD((int)blockIdx.x);
    for (int u = blockIdx.x; u < 3072; u += gridDim.x) {
        ATT_DECODE(u) (void)base;
        __syncthreads();
#pragma unroll
        for (int i = 0; i < 4; ++i) { const int c = tid + 512 * i, key = c >> 3, part = c & 7;
            *(LAS u32x4*)(Ks + key * 144 + part * 16) = pk_[i];
            *(LAS u32x4*)(Vt + key * 144 + part * 16) = pv_[i]; }
        const int qi = 16 * wid + fr; bf16x8 qf[2]; qf[0] = pq_[0]; qf[1] = pq_[1];
        __syncthreads();
        if (u + (int)gridDim.x < 3072) ATT_LOAD(u + (int)gridDim.x);
        f32x4 st[10]; float m = -INFINITY;
#pragma unroll
        for (int T = 0; T < 10; ++T) { const int Tt = T0 + T;
            const bf16x8 k0 = *(const LAS bf16x8*)(Ks + (16 * Tt + fr) * 144 + fq * 16), k1 = *(const LAS bf16x8*)(Ks + (16 * Tt + fr) * 144 + 64 + fq * 16);
            f32x4 acc = (f32x4){0.f, 0.f, 0.f, 0.f};
            acc = __builtin_amdgcn_mfma_f32_16x16x32_bf16(k0, qf[0], acc, 0, 0, 0); acc = __builtin_amdgcn_mfma_f32_16x16x32_bf16(k1, qf[1], acc, 0, 0, 0);
            const int rel = Tt - wid;
            if (rel < 0 || rel > 8 || (n == 0 && Tt < 8)) { acc = (f32x4){-INFINITY, -INFINITY, -INFINITY, -INFINITY}; }
            else if (rel == 0) {
#pragma unroll
                for (int rg = 0; rg < 4; ++rg) { const float s = (4 * fq + rg >= fr) ? acc[rg] * 0.125f : -INFINITY; acc[rg] = s; m = fmaxf(m, s); } }
            else if (rel == 8) {
#pragma unroll
                for (int rg = 0; rg < 4; ++rg) { const float s = (4 * fq + rg <= fr) ? acc[rg] * 0.125f : -INFINITY; acc[rg] = s; m = fmaxf(m, s); } }
            else {
#pragma unroll
                for (int rg = 0; rg < 4; ++rg) { const float s = acc[rg] * 0.125f; acc[rg] = s; m = fmaxf(m, s); } }
            st[T] = acc; }
        m = fmaxf(m, __shfl_xor(m, 16)); m = fmaxf(m, __shfl_xor(m, 32));
        float den = 0.f;
#pragma unroll
        for (int T = 0; T < 10; ++T)
#pragma unroll
            for (int rg = 0; rg < 4; ++rg) { const float p = __expf(st[T][rg] - m); st[T][rg] = p; den += p; }
        den += __shfl_xor(den, 16); den += __shfl_xor(den, 32);
        f32x4 o[4];
#pragma unroll
        for (int nt = 0; nt < 4; ++nt) o[nt] = (f32x4){0.f, 0.f, 0.f, 0.f};
        const unsigned vaddr = (unsigned)(size_t)Vt + (unsigned)((4 * fq + (fr >> 2)) * 144 + (fr & 3) * 8);
#pragma unroll
        for (int s2 = 0; s2 < 5; ++s2) { const int Ta = T0 + 2 * s2;
            u32x4 pw; pw.x = pk_bf16(st[2 * s2][0], st[2 * s2][1]); pw.y = pk_bf16(st[2 * s2][2], st[2 * s2][3]); pw.z = pk_bf16(st[2 * s2 + 1][0], st[2 * s2 + 1][1]); pw.w = pk_bf16(st[2 * s2 + 1][2], st[2 * s2 + 1][3]);
            const bf16x8 pa = __builtin_bit_cast(bf16x8, pw);
            const unsigned va = vaddr + (unsigned)(16 * Ta * 144);
            u32x2 a0, a1, a2, a3, b0, b1, b2, b3;
            asm volatile("ds_read_b64_tr_b16 %0, %8\n\tds_read_b64_tr_b16 %1, %8 offset:32\n\tds_read_b64_tr_b16 %2, %8 offset:64\n\tds_read_b64_tr_b16 %3, %8 offset:96\n\t"
                         "ds_read_b64_tr_b16 %4, %8 offset:2304\n\tds_read_b64_tr_b16 %5, %8 offset:2336\n\tds_read_b64_tr_b16 %6, %8 offset:2368\n\tds_read_b64_tr_b16 %7, %8 offset:2400\n\t"
                         "s_waitcnt lgkmcnt(0)"
                         : "=&v"(a0), "=&v"(a1), "=&v"(a2), "=&v"(a3), "=&v"(b0), "=&v"(b1), "=&v"(b2), "=&v"(b3) : "v"(va) : "memory");
            { u32x4 vw; vw.x = a0.x; vw.y = a0.y; vw.z = b0.x; vw.w = b0.y; o[0] = __builtin_amdgcn_mfma_f32_16x16x32_bf16(pa, __builtin_bit_cast(bf16x8, vw), o[0], 0, 0, 0); }
            { u32x4 vw; vw.x = a1.x; vw.y = a1.y; vw.z = b1.x; vw.w = b1.y; o[1] = __builtin_amdgcn_mfma_f32_16x16x32_bf16(pa, __builtin_bit_cast(bf16x8, vw), o[1], 0, 0, 0); }
            { u32x4 vw; vw.x = a2.x; vw.y = a2.y; vw.z = b2.x; vw.w = b2.y; o[2] = __builtin_amdgcn_mfma_f32_16x16x32_bf16(pa, __builtin_bit_cast(bf16x8, vw), o[2], 0, 0, 0); }
            { u32x4 vw; vw.x = a3.x; vw.y = a3.y; vw.z = b3.x; vw.w = b3.y; o[3] = __builtin_amdgcn_mfma_f32_16x16x32_bf16(pa, __builtin_bit_cast(bf16x8, vw), o[3], 0, 0, 0); } }
        const float inv = __builtin_amdgcn_rcpf(den);
        if (fq == 0) { const size_t pos = ((size_t)(128 * n + qi) << dl) + r; LSE[((size_t)g * CH + (size_t)bl * SEQ + pos) * 8 + h] = m + __logf(den); }
#pragma unroll
        for (int rg = 0; rg < 4; ++rg) { const float iv = __shfl(inv, 4 * fq + rg); const int q = 16 * wid + 4 * fq + rg; const size_t pos = ((size_t)(128 * n + q) << dl) + r;
            bf16_t* op = ATTO + ((size_t)g * CH + (size_t)bl * SEQ + pos) * 512 + h * 64 + fr;
#pragma unroll
            for (int nt = 0; nt < 4; ++nt) op[16 * nt] = f2bf(o[nt][rg] * iv); }
    }
#undef ATT_DECODE
#undef ATT_LOAD
}

__device__ __forceinline__ void combine_phase(const int WV, kargs_t A, const size_t roff) {
    const bf16_t* ATTO = (const bf16_t*)(A->ws + WS_ATTO); const float* LSE = (const float*)(A->ws + WS_LSE); bf16_t* ATTM = (bf16_t*)(A->ws + WS_ATTM) + roff * 512;
    const size_t gtid = (size_t)blockIdx.x * NTHREADS + ltid(), gsz = (size_t)gridDim.x * NTHREADS;
    for (size_t it = gtid; it < (size_t)CH * 64; it += gsz) {
        const size_t row = it >> 6; const int ch = (int)(it & 63), h = ch >> 3;
        const float l0 = LSE[(0 * (size_t)CH + row) * 8 + h], l1 = LSE[(1 * (size_t)CH + row) * 8 + h], l2 = LSE[(2 * (size_t)CH + row) * 8 + h];
        const float mx = fmaxf(l0, fmaxf(l1, l2)); float w0 = __expf(l0 - mx), w1 = __expf(l1 - mx), w2 = __expf(l2 - mx); const float is = __builtin_amdgcn_rcpf(w0 + w1 + w2); w0 *= is; w1 *= is; w2 *= is;
        const u32x4 a0 = *(const u32x4*)(ATTO + (0 * (size_t)CH + row) * 512 + ch * 8), a1 = *(const u32x4*)(ATTO + (1 * (size_t)CH + row) * 512 + ch * 8), a2 = *(const u32x4*)(ATTO + (2 * (size_t)CH + row) * 512 + ch * 8);
        u32x4 o;
        o.x = pk_bf16(w0 * bf_lo(a0.x) + w1 * bf_lo(a1.x) + w2 * bf_lo(a2.x), w0 * bf_hi(a0.x) + w1 * bf_hi(a1.x) + w2 * bf_hi(a2.x));
        o.y = pk_bf16(w0 * bf_lo(a0.y) + w1 * bf_lo(a1.y) + w2 * bf_lo(a2.y), w0 * bf_hi(a0.y) + w1 * bf_hi(a1.y) + w2 * bf_hi(a2.y));
        o.z = pk_bf16(w0 * bf_lo(a0.z) + w1 * bf_lo(a1.z) + w2 * bf_lo(a2.z), w0 * bf_hi(a0.z) + w1 * bf_hi(a1.z) + w2 * bf_hi(a2.z));
        o.w = pk_bf16(w0 * bf_lo(a0.w) + w1 * bf_lo(a1.w) + w2 * bf_lo(a2.w), w0 * bf_hi(a0.w) + w1 * bf_hi(a1.w) + w2 * bf_hi(a2.w));
        *(u32x4*)(ATTM + row * 512 + ch * 8) = o;
    }
}

constexpr int CONV_RS = 32;
__device__ __forceinline__ void halo_phase(const int WV, kargs_t A) {
    const bf16_t* U = (const bf16_t*)(A->ws + WS_U); bf16_t* HALO = (bf16_t*)(A->ws + WS_HALO);
    const size_t gtid = (size_t)blockIdx.x * NTHREADS + ltid(), gsz = (size_t)gridDim.x * NTHREADS;
    for (size_t it = gtid; it < (size_t)(MTOK / CONV_RS) * 2 * 704; it += gsz) {
        const int ch = (int)(it % 704); const size_t sr = it / 704; const int which = (int)(sr & 1); const size_t seg = sr >> 1; const size_t row0 = seg * CONV_RS;
        u32x4 v = (u32x4){0u, 0u, 0u, 0u};
        if ((row0 & 4095) != 0) v = *(const u32x4*)(U + (row0 - 1 - which) * 5632 + ch * 8);
        *(u32x4*)(HALO + (seg * 2 + which) * 5632 + ch * 8) = v;
    }
}
__device__ __forceinline__ void conv_phase(const int WV, kargs_t A, unsigned* bar, volatile LAS unsigned* bst, const bool one_launch) {
    bf16_t* U = (bf16_t*)(A->ws + WS_U); bf16_t* HALO = (bf16_t*)(A->ws + WS_HALO); const float* cw = A->in[I_CONVW]; const float* cb = A->in[I_CONVB];
    const size_t gtid = (size_t)blockIdx.x * NTHREADS + ltid(), gsz = (size_t)gridDim.x * NTHREADS;
    constexpr int R = CONV_RS; constexpr int MAXIT = 3;
    const size_t nitems = (size_t)(MTOK / R) * 352;
    const bool fits = nitems <= (size_t)MAXIT * gsz;
    if (one_launch && !fits) {
        for (size_t it = gtid; it < (size_t)(MTOK / R) * 2 * 704; it += gsz) { const int ch = (int)(it % 704); const size_t sr = it / 704; const int which = (int)(sr & 1); const size_t seg = sr >> 1; const size_t row0 = seg * R;
            u32x4 v = (u32x4){0u, 0u, 0u, 0u}; if ((row0 & 4095) != 0) v = *(const u32x4*)(U + (row0 - 1 - which) * 5632 + ch * 8);
            *(u32x4*)(HALO + (seg * 2 + which) * 5632 + ch * 8) = v; }
        xcd_barrier(WV, bar, bst);
    }
    const bool from_u = one_launch && fits;
    auto process = [&](const size_t it, const u32x4 (&hh1)[2], const u32x4 (&hh2)[2]) {
        const size_t seg = it / 352; const int j = (int)(it % 352) * 8; const size_t row0 = seg * R;
        f32x4 wb[2][2], w0[2][2], w1[2][2], w2[2][2];
#pragma unroll
        for (int s2 = 0; s2 < 2; ++s2)
#pragma unroll
            for (int q = 0; q < 2; ++q) { const int c = s2 * DFF + j + 4 * q; wb[s2][q] = *(const f32x4*)(cb + c); w0[s2][q] = *(const f32x4*)(cw + c); w1[s2][q] = *(const f32x4*)(cw + 5632 + c); w2[s2][q] = *(const f32x4*)(cw + 2 * 5632 + c); }
        u32x4 p1[2], p2[2];
#pragma unroll
        for (int s2 = 0; s2 < 2; ++s2) { p1[s2] = hh1[s2]; p2[s2] = hh2[s2]; }
#pragma unroll 4
        for (int rr = 0; rr < R; ++rr) {
            const size_t row = row0 + rr; u32x4 u0[2]; float res[2][8];
#pragma unroll
            for (int s2 = 0; s2 < 2; ++s2) u0[s2] = *(const u32x4*)(U + row * 5632 + s2 * DFF + j);
#pragma unroll
            for (int s2 = 0; s2 < 2; ++s2) {
                const float x0[8] = {bf_lo(u0[s2].x), bf_hi(u0[s2].x), bf_lo(u0[s2].y), bf_hi(u0[s2].y), bf_lo(u0[s2].z), bf_hi(u0[s2].z), bf_lo(u0[s2].w), bf_hi(u0[s2].w)};
                const float x1[8] = {bf_lo(p1[s2].x), bf_hi(p1[s2].x), bf_lo(p1[s2].y), bf_hi(p1[s2].y), bf_lo(p1[s2].z), bf_hi(p1[s2].z), bf_lo(p1[s2].w), bf_hi(p1[s2].w)};
                const float x2[8] = {bf_lo(p2[s2].x), bf_hi(p2[s2].x), bf_lo(p2[s2].y), bf_hi(p2[s2].y), bf_lo(p2[s2].z), bf_hi(p2[s2].z), bf_lo(p2[s2].w), bf_hi(p2[s2].w)};
#pragma unroll
                for (int q = 0; q < 2; ++q)
#pragma unroll
                    for (int i = 0; i < 4; ++i) res[s2][4 * q + i] = wb[s2][q][i] + w0[s2][q][i] * x2[4 * q + i] + w1[s2][q][i] * x1[4 * q + i] + w2[s2][q][i] * x0[4 * q + i];
                p2[s2] = p1[s2]; p1[s2] = u0[s2];
            }
            float o[8];
#pragma unroll
            for (int i = 0; i < 8; ++i) { const float gt = res[0][i]; o[i] = gt * sigm(gt) * res[1][i]; }
            u32x4 w; w.x = pk_bf16(o[0], o[1]); w.y = pk_bf16(o[2], o[3]); w.z = pk_bf16(o[4], o[5]); w.w = pk_bf16(o[6], o[7]);
            *(u32x4*)(U + row * 5632 + j) = w;
        }
    };
    auto load_halo = [&](const size_t it, u32x4 (&hh1)[2], u32x4 (&hh2)[2], const bool fu) {
        const size_t seg = it / 352; const int j = (int)(it % 352) * 8; const size_t row0 = seg * R;
#pragma unroll
        for (int s2 = 0; s2 < 2; ++s2) { hh1[s2] = (u32x4){0u, 0u, 0u, 0u}; hh2[s2] = (u32x4){0u, 0u, 0u, 0u};
            if (fu) { if ((row0 & 4095) != 0) { hh1[s2] = *(const u32x4*)(U + (row0 - 1) * 5632 + s2 * DFF + j); hh2[s2] = *(const u32x4*)(U + (row0 - 2) * 5632 + s2 * DFF + j); } }
            else { hh1[s2] = *(const u32x4*)(HALO + (seg * 2 + 0) * 5632 + s2 * DFF + j); hh2[s2] = *(const u32x4*)(HALO + (seg * 2 + 1) * 5632 + s2 * DFF + j); } }
    };
    u32x4 h1[MAXIT][2], h2[MAXIT][2];
#pragma unroll
    for (int k = 0; k < MAXIT; ++k) { const size_t it = gtid + (size_t)k * gsz; if (it < nitems) load_halo(it, h1[k], h2[k], from_u); }
    if (from_u) xcd_barrier(WV, bar, bst);
#pragma unroll
    for (int k = 0; k < MAXIT; ++k) { const size_t it = gtid + (size_t)k * gsz; if (it < nitems) process(it, h1[k], h2[k]); }
    for (size_t it = gtid + (size_t)MAXIT * gsz; it < nitems; it += gsz) { u32x4 a1[2], a2[2]; load_halo(it, a1, a2, false); process(it, a1, a2); }
}

template <int MODE> __device__ __forceinline__ void gemm_call(const int WV, lds_t lds, const pg8::Gemm g, const pg8::EpiArgs ea) {
    pg8::StaticOrder S; S.init(g.M, g.N, (int)gridDim.x, (int)blockIdx.x); pg8::Epi<MODE> E; E.a = ea; pg8::gemm_phase(WV, lds, g, S, E);
}
template <unsigned KM> __global__ void __launch_bounds__(NTHREADS, 2) fwd_kernel(Args Aval) {
    extern __shared__ __attribute__((aligned(16))) unsigned char lds_raw[];
    lds_t lds = (lds_t)lds_raw;
    const kargs_t A0 = (kargs_t)__builtin_amdgcn_kernarg_segment_ptr();
    const int WV = __builtin_amdgcn_readfirstlane(threadIdx.x >> 6);
    const int lo = A0->ph_lo, hi = A0->ph_hi; int ph = 0;
    unsigned* const bar = (unsigned*)(A0->ws + WS_BAR);
    volatile LAS unsigned* const bst = (volatile LAS unsigned*)(lds + 131072);
    if (hi > N_PHASES) cg::this_grid().sync();
    if (hi - lo > 1) {
        if (ltid() == 0) { bst[0] = 0u; bst[1] = 0u; (void)xb_add(&bar[XB_XCNT(xb_xcc_id())], 1u); }
        __syncthreads();
    }
    const int G = gridDim.x, bid = blockIdx.x;
#ifndef REP_MASK
#define REP_MASK 0u
#endif
#ifndef KIND_MASK
#define KIND_MASK 0xFFFFFFFFu
#endif
#define PH_BEGIN(k) if (ph >= lo && ph < hi) { if constexpr (((KM) >> (k)) & 1u) { for (int rep_ = 0; rep_ < ((((REP_MASK) >> (k)) & 1u) ? 2 : 1); ++rep_) { if (rep_) xcd_barrier(WV, bar, bst); const kargs_t A = launder_args(A0); unsigned char* const ws = A->ws; const float* const ada = (const float*)(ws + WS_ADA); (void)ada;
#define PH_END } } if (ph + 1 < hi) { xcd_barrier(WV, bar, bst); } } ++ph;
    using namespace pg8;
#ifdef PROBE_SYNCS
    if (hi - lo > 1) { for (int i_ = 0; i_ < PROBE_SYNCS; ++i_) cg::this_grid().sync(); }
#endif
    PH_BEGIN(0) p0_weights(WV, A, lds); PH_END
    PH_BEGIN(1) norm_rows<true, true>(WV, A->in[I_X], A->in[I_N1W], ada + 0, ada + 1024, ws + WS_H1, MTOK, 0); PH_END
    PH_BEGIN(2) { Gemm g{(const bf16_t*)(ws + WS_H1), (const bf16_t*)(ws + WS_WINRW), MTOK, NRW, 1024, 1024, 1024}; EpiArgs ea{}; ea.o0 = (bf16_t*)(ws + WS_PRW); ea.ld0 = NRW; ea.ncol0 = 1 << 30; gemm_call<EP_BF16>(WV, lds, g, ea); } PH_END
    PH_BEGIN(3) lora_prep(WV, A); PH_END
    PH_BEGIN(4) { Gemm g{(const bf16_t*)(ws + WS_ALORA), (const bf16_t*)(ws + WS_WLORA), MTOK, 2048, 256, 384, 384}; EpiArgs ea{}; ea.o0 = (bf16_t*)(ws + WS_EA); ea.ld0 = 2048; ea.p0 = A->in[I_W0]; ea.p1 = A->in[I_A0]; gemm_call<EP_EA>(WV, lds, g, ea); } PH_END
    PH_BEGIN(5) scan_phase(WV, A, lds); PH_END
    PH_BEGIN(6) { Gemm g{(const bf16_t*)(ws + WS_ALORA) + 128, (const bf16_t*)(ws + WS_WLORA) + (size_t)2048 * 384 + 128, MTOK, 1024, 256, 384, 384}; EpiArgs ea{}; ea.o0 = (bf16_t*)(ws + WS_G); ea.ld0 = 1024; ea.ncol0 = 1 << 30; gemm_call<EP_BF16>(WV, lds, g, ea); } PH_END
    PH_BEGIN(7) post_phase(WV, A); PH_END
    for (int ck = 0; ck < 2; ++ck) {
        const size_t roff = (size_t)ck * CH;
        if (ck == 0) { PH_BEGIN(8) norm_rows<true, true>(WV, A->in[I_X], A->in[I_N1W], ada + 0, ada + 1024, ws + WS_H1C, CH, 0); PH_END }
        PH_BEGIN(9) { Gemm g{(const bf16_t*)(ws + WS_H1C), (const bf16_t*)(ws + WS_WINAG), CH, NAG, 1024, 1024, 1024}; EpiArgs ea{}; ea.o0 = (bf16_t*)(ws + WS_PATT); ea.ld0 = 4608; ea.ncol0 = 4608; ea.o1 = (bf16_t*)(ws + WS_PGATE) + roff * 2048; ea.ld1 = 2048; gemm_call<EP_BF16>(WV, lds, g, ea); } PH_END
        PH_BEGIN(10) attn_phase(WV, A, lds); PH_END
        PH_BEGIN(11) combine_phase(WV, A, roff);
                     if (ck == 0) norm_rows<true, true>(WV, A->in[I_X] + (size_t)CH * 1024, A->in[I_N1W], ada + 0, ada + 1024, ws + WS_H1C, CH, CH); PH_END
    }
    PH_BEGIN(12) { { Gemm g{(const bf16_t*)(ws + WS_ATTM), (const bf16_t*)(ws + WS_WATTO), MTOK, 1024, 512, 512, 512}; EpiArgs ea{}; ea.gate = (const bf16_t*)(ws + WS_PGATE); ea.p0 = A->in[I_BGATE]; ea.t1 = (float*)(ws + WS_T1); gemm_call<EP_ATTOUT>(WV, lds, g, ea); }
                   { Gemm g{(const bf16_t*)(ws + WS_RWO), (const bf16_t*)(ws + WS_WRWO), MTOK, 1024, 1024, 1024, 1024}; EpiArgs ea{}; ea.gate = (const bf16_t*)(ws + WS_PGATE); ea.p0 = A->in[I_BGATE]; ea.t1 = (float*)(ws + WS_T1); ea.o0 = (bf16_t*)(ws + WS_MIX); gemm_call<EP_RWOUT>(WV, lds, g, ea); } } PH_END
    PH_BEGIN(14) { Gemm g{(const bf16_t*)(ws + WS_MIX), (const bf16_t*)(ws + WS_WO), MTOK, 1024, 1024, 1024, 1024}; EpiArgs ea{}; ea.p0 = ada + 2048; ea.row0g = 0; ea.base = A->in[I_X]; ea.outf = A->out; gemm_call<EP_RESID>(WV, lds, g, ea); } PH_END
    PH_BEGIN(15) p_ffn_weights(WV, A, lds);
                 norm_rows<true, true>(WV, A->out, A->in[I_N2W], ada + 3072, ada + 4096, ws + WS_H2, MTOK, 0); PH_END
    PH_BEGIN(16) { Gemm g{(const bf16_t*)(ws + WS_H2), (const bf16_t*)(ws + WS_WUP), MTOK, 5632, 1024, 1024, 1024}; EpiArgs ea{}; ea.o0 = (bf16_t*)(ws + WS_U); ea.ld0 = 5632; ea.ncol0 = 1 << 30; gemm_call<EP_BF16>(WV, lds, g, ea); } PH_END
#if !MK_ONE_LAUNCH
    PH_BEGIN(13) halo_phase(WV, A); PH_END
#endif
    PH_BEGIN(17) conv_phase(WV, A, bar, bst, MK_ONE_LAUNCH != 0); PH_END
    PH_BEGIN(18) { Gemm g{(const bf16_t*)(ws + WS_U), (const bf16_t*)(ws + WS_WDN), MTOK, 1024, DFF, 5632, DFF}; EpiArgs ea{}; ea.p0 = ada + 5120; ea.row0g = 0; ea.base = A->out; ea.outf = A->out; gemm_call<EP_RESID>(WV, lds, g, ea); } PH_END
    PH_BEGIN(19) norm_rows<false, false>(WV, A->out, A->in[I_NFW], nullptr, nullptr, A->out, MTOK, 0); PH_END
#undef PH_BEGIN
#undef PH_END
}

constexpr unsigned LIGHT_MASK = (1u << 0) | (1u << 1) | (1u << 3) | (1u << 7) | (1u << 8) | (1u << 11) | (1u << 13) | (1u << 15) | (1u << 17) | (1u << 19);
#if MK_ONE_LAUNCH
static const int kind_of_phase[N_PHASES] = {0, 1, 2, 3, 4, 5, 6, 7, 8, 9, 10, 11, 9, 10, 11, 12, 14, 15, 16, 17, 18, 19};
#else
static const int kind_of_phase[N_PHASES] = {0, 1, 2, 3, 4, 5, 6, 7, 8, 9, 10, 11, 9, 10, 11, 12, 14, 15, 16, 13, 17, 18, 19};
#endif
typedef void (*kfn_t)(Args);
static kfn_t kernel_for_kind(int k) {
#if MK_ONE_LAUNCH
    (void)k; return fwd_kernel<0xFFFFFu>;
#else
    switch (k) {
        case 2: return fwd_kernel<1u << 2>; case 4: return fwd_kernel<1u << 4>; case 5: return fwd_kernel<1u << 5>; case 6: return fwd_kernel<1u << 6>;
        case 9: return fwd_kernel<1u << 9>; case 10: return fwd_kernel<1u << 10>; case 12: return fwd_kernel<1u << 12>; case 13: return fwd_kernel<1u << 13>;
        case 14: return fwd_kernel<1u << 14>; case 16: return fwd_kernel<1u << 16>; case 18: return fwd_kernel<1u << 18>;
        default: return fwd_kernel<LIGHT_MASK>;
    }
#endif
}
extern "C" void kernel_launch(void* const* d_in, const int* in_sizes, int n_in, void* d_out, int out_size, void* d_ws, size_t ws_size, hipStream_t stream) {
    static int grid = 0;
    if (grid == 0) {
        if (n_in != 27 || out_size != MTOK * D || ws_size < WS_NEED) { fprintf(stderr, "kernel_launch: unexpected shapes (n_in %d out %d ws %zu, need %zu)\n", n_in, out_size, ws_size, (size_t)WS_NEED); grid = -1; return; }
        int dev = 0, cus = 0;
        if (hipGetDevice(&dev) != hipSuccess || hipDeviceGetAttribute(&cus, hipDeviceAttributeMultiprocessorCount, dev) != hipSuccess) cus = 256;
        for (int k = 0; k < 20; ++k)
            if (hipFuncSetAttribute((const void*)kernel_for_kind(k), hipFuncAttributeMaxDynamicSharedMemorySize, LDS_BYTES) != hipSuccess) { fprintf(stderr, "kernel_launch: hipFuncSetAttribute failed\n"); grid = -1; return; }
        (void)hipGetLastError();
        grid = cus > 0 ? cus : 256;
    }
    if (grid < 0) return;
    Args a{};
    for (int i = 0; i < 27; ++i) a.in[i] = (const float*)d_in[i];
    a.out = (float*)d_out; a.ws = (unsigned char*)d_ws;
#if MK_ONE_LAUNCH
    a.ph_lo = 0; a.ph_hi = N_PHASES;
    if (hipMemsetAsync((char*)d_ws + WS_BAR, 0, XCD_BAR_WORDS * sizeof(unsigned), stream) != hipSuccess) { fprintf(stderr, "kernel_launch: memset of barrier words failed\n"); return; }
    void* args[] = {&a};
    hipError_t e = hipLaunchCooperativeKernel((const void*)fwd_kernel<0xFFFFFu>, dim3(grid), dim3(NTHREADS), args, LDS_BYTES, stream);
    if (e != hipSuccess) fprintf(stderr, "kernel_launch: cooperative launch failed: %s (grid %d)\n", hipGetErrorString(e), grid);
#else
    for (int p = 0; p < N_PHASES; ++p) {
        a.ph_lo = p; a.ph_hi = p + 1;
        hipLaunchKernelGGL(kernel_for_kind(kind_of_phase[p]), dim3(grid), dim3(NTHREADS), LDS_BYTES, stream, a);
    }
#endif
}
```

```cpp
#include <hip/hip_runtime.h>
#include <hip/hip_cooperative_groups.h>
#include <cstdio>
#include <cstdint>
namespace cg = cooperative_groups;

#ifndef MK_ONE_LAUNCH
#define MK_ONE_LAUNCH 1
#endif

#define LAS __attribute__((address_space(3)))
typedef unsigned short bf16_t;
typedef short bf16x8 __attribute__((ext_vector_type(8)));
typedef float f32x4 __attribute__((ext_vector_type(4)));
typedef float f32x2 __attribute__((ext_vector_type(2)));
typedef unsigned u32x4 __attribute__((ext_vector_type(4)));
typedef unsigned u32x2 __attribute__((ext_vector_type(2)));
typedef LAS unsigned char* lds_t;

constexpr int SEQ = 4096, NB = 8, D = 1024, MTOK = NB * SEQ;
constexpr int NRW = 3584;
constexpr int NAG = 6656;
constexpr int DFF = 2816;
constexpr int CH = 16384;
constexpr int NTHREADS = 512;
constexpr int LDS_BYTES = 131072 + 16;
constexpr int N_PHASES = 8 + (4 + 3) + 2 + (MK_ONE_LAUNCH ? 5 : 6);

constexpr size_t MiB = 1048576;
constexpr size_t WS_WATTO = 0 * MiB, WS_WRWO = 1 * MiB, WS_WO = 3 * MiB, WS_WLORA = 5 * MiB, WS_ADA = 7 * MiB + 512 * 1024;
constexpr size_t WS_WINRW = 8 * MiB, WS_WINAG = 15 * MiB;
constexpr size_t WS_H1 = 45 * MiB, WS_Y = 45 * MiB, WS_PRW = 109 * MiB, WS_ALORA = 333 * MiB, WS_EA = 357 * MiB, WS_BS = 485 * MiB;
constexpr size_t WS_G = 357 * MiB, WS_RWO = 421 * MiB;
constexpr size_t WS_H1C = 28 * MiB, WS_PATT = 60 * MiB, WS_ATTO = 204 * MiB, WS_LSE = 8 * MiB, WS_PGATE = 252 * MiB, WS_ATTM = 380 * MiB;
constexpr size_t WS_T1 = 28 * MiB, WS_MIX = 156 * MiB;
constexpr size_t WS_WUP = 8 * MiB, WS_WDN = 19 * MiB, WS_H2 = 28 * MiB, WS_U = 92 * MiB, WS_HALO = 444 * MiB;
constexpr size_t WS_BAR = 503 * MiB;
constexpr size_t WS_NEED = 504 * MiB;

__device__ __forceinline__ float bf_lo(unsigned u) { return __uint_as_float(u << 16); }
__device__ __forceinline__ float bf_hi(unsigned u) { return __uint_as_float(u & 0xffff0000u); }
__device__ __forceinline__ float bf2f(bf16_t v) { return __uint_as_float(((unsigned)v) << 16); }
__device__ __forceinline__ unsigned pk_bf16(float lo, float hi) { unsigned r; asm volatile("v_cvt_pk_bf16_f32 %0, %1, %2" : "=v"(r) : "v"(lo), "v"(hi)); return r; }
__device__ __forceinline__ bf16_t f2bf(float f) { return (bf16_t)(pk_bf16(f, 0.f) & 0xffffu); }
__device__ __forceinline__ int lane_id_asm() { int l; asm volatile("v_mbcnt_lo_u32_b32 %0, -1, 0\n\tv_mbcnt_hi_u32_b32 %0, -1, %0" : "=v"(l)); return l; }
__device__ __forceinline__ int ltid_w(int w) { asm volatile("" : "+s"(w)); return w * 64 + lane_id_asm(); }
#define ltid() ltid_w(WV)
__device__ __forceinline__ float sigm(float x) { return __builtin_amdgcn_rcpf(1.0f + __expf(-x)); }
template <int CTRL> __device__ __forceinline__ float dppf(float x) { return __builtin_bit_cast(float, __builtin_amdgcn_mov_dpp(__builtin_bit_cast(int, x), CTRL, 0xf, 0xf, true)); }
__device__ __forceinline__ float allred16(float x) { x += dppf<0xB1>(x); x += dppf<0x4E>(x); x += dppf<0x141>(x); x += dppf<0x128>(x); return x; }

namespace pg8 {
constexpr int BM = 256, BK = 64, HALF = 128, HTB = HALF * BK * 2, STAGE_BYTES = 8 * HTB, NXCD = 8, WGM = 2;
__host__ __device__ __forceinline__ int lds_byte(int r, int c) { const int st = (r >> 4) * 2 + (c >> 5), rr = r & 15, cc = c & 31, ob = rr * 64 + cc * 2; return st * 1024 + (ob ^ (((ob >> 9) & 1) << 5)); }
__host__ __device__ __forceinline__ void stage_rc(int b, int& R, int& C) { const int st = b / 1024, sb = b % 1024, swz = sb ^ (((sb >> 9) & 1) << 5); R = (st >> 1) * 16 + swz / 64; C = (st & 1) * 32 + (swz % 64) / 2; }
__host__ __device__ __forceinline__ int perm32(int rho) { const int n = rho >> 4, i = rho & 15; return 8 * (i >> 2) + 4 * n + (i & 3); }
struct Unit { int pm, pn; };
struct Gemm { const bf16_t* A; const bf16_t* Bt; int M, N, K, lda, ldb; };
struct StaticOrder {
    int nM, nN, nwg, G, c;
    __device__ void init(int M, int N, int G_, int c_) { nM = M / BM; nN = N / BM; nwg = nM * nN; G = G_; c = c_; }
    __device__ bool next(int i, Unit& u) const {
        const long L = (long)i * G + c; if (L >= nwg) return false;
        int wgid = (int)L; { const int q = nwg / NXCD, r = nwg % NXCD, xcd = wgid % NXCD, off = wgid / NXCD; wgid = (xcd < r ? xcd * (q + 1) : r * (q + 1) + (xcd - r) * q) + off; }
        const int nig = WGM * nN, gid = wgid / nig, fm = gid * WGM, gsz = (nM - fm) < WGM ? (nM - fm) : WGM;
        u.pm = fm + ((wgid % nig) % gsz); u.pn = (wgid % nig) / gsz; return true;
    }
};

template <class Epi, bool ALIGN_EPI = true>
__device__ __forceinline__ void gemm_phase(const int WV, lds_t lds, const Gemm g, const StaticOrder& S, const Epi& E) {
    const int tid = ltid(), wid = __builtin_amdgcn_readfirstlane(tid >> 6), lane = tid & 63, wr = wid >> 2, wc = wid & 3, fr = lane & 15, fq = lane >> 4;
    const int K = g.K, nt = K / BK;
    unsigned voffA[2], voffB[2];
#pragma unroll
    for (int i = 0; i < 2; ++i) { int R, C; stage_rc(tid * 16 + i * 8192, R, C); const int Rb = Epi::PERM ? ((R & ~31) + perm32(R & 31)) : R;
        voffA[i] = (unsigned)(R * g.lda + C) * 2u; voffB[i] = (unsigned)(Rb * g.ldb + C) * 2u; }
    const size_t kstep = (size_t)(BK * 2);
    const size_t hstepA = (size_t)HALF * g.lda * 2, hstepB = (size_t)HALF * g.ldb * 2;
    const size_t tstepA = 2 * hstepA, tstepB = 2 * hstepB;
    const unsigned ldsw = (unsigned)wid * 1024u;
    const int aoff = lds_byte(wr * 64 + fr, fq * 8), boff = lds_byte(wc * 32 + fr, fq * 8);
#define PG8_SA(b, h) (((b) * 2 + (h)) * HTB)
#define PG8_SB(b, h) ((4 + (b) * 2 + (h)) * HTB)
#define PG8_STAGE(bufoff, gbase, voff) do { _Pragma("unroll") for (int _i = 0; _i < 2; ++_i) \
        __builtin_amdgcn_global_load_lds((const unsigned*)((const char*)(gbase) + (voff)[_i]), (LAS unsigned*)(lds + (bufoff) + ldsw + _i * 8192), 16, 0, 0); } while (0)
#define PG8_LDA(dst, b, h) do { _Pragma("unroll") for (int m = 0; m < 4; ++m) _Pragma("unroll") for (int k = 0; k < 2; ++k) dst[m][k] = *(const LAS bf16x8*)(lds + PG8_SA(b, h) + aoff + m * 2048 + k * 1024); } while (0)
#define PG8_LDB(dst, b, h) do { _Pragma("unroll") for (int n = 0; n < 2; ++n) _Pragma("unroll") for (int k = 0; k < 2; ++k) dst[n][k] = *(const LAS bf16x8*)(lds + PG8_SB(b, h) + boff + n * 2048 + k * 1024); } while (0)
#define PG8_MMA(ai, bj, At, Bt) do { __builtin_amdgcn_s_setprio(1); _Pragma("unroll") for (int m = 0; m < 4; ++m) _Pragma("unroll") for (int n = 0; n < 2; ++n) _Pragma("unroll") for (int k = 0; k < 2; ++k) \
        acc[ai][bj][m][n] = __builtin_amdgcn_mfma_f32_16x16x32_bf16(Bt[n][k], At[m][k], acc[ai][bj][m][n], 0, 0, 0); __builtin_amdgcn_s_setprio(0); } while (0)
#define PG8_WAIT_V(n) asm volatile("s_waitcnt vmcnt(" #n ")" ::: "memory")
#define PG8_WAIT_L(n) asm volatile("s_waitcnt lgkmcnt(" #n ")" ::: "memory")
#define PG8_BAR __builtin_amdgcn_s_barrier()
#define PG8_SCHED __builtin_amdgcn_sched_barrier(0)
    Unit cur, nxt; int ui = 0;
    if (!S.next(0, cur)) return;
    f32x4 acc[2][2][4][2];
#pragma unroll
    for (int a = 0; a < 2; ++a)
#pragma unroll
        for (int b = 0; b < 2; ++b)
#pragma unroll
            for (int m = 0; m < 4; ++m)
#pragma unroll
                for (int n = 0; n < 2; ++n) acc[a][b][m][n] = (f32x4){0.f, 0.f, 0.f, 0.f};
    bf16x8 At[4][2], B0[2][2], B1[2][2];
    const char* cA = (const char*)g.A + (size_t)cur.pm * tstepA; const char* cB = (const char*)g.Bt + (size_t)cur.pn * tstepB;
    PG8_STAGE(PG8_SB(0, 0), cB, voffB); PG8_STAGE(PG8_SB(0, 1), cB + hstepB, voffB); PG8_STAGE(PG8_SA(0, 0), cA, voffA); PG8_STAGE(PG8_SA(0, 1), cA + hstepA, voffA);
    if (wr == 1) PG8_BAR;
    PG8_WAIT_V(2); PG8_BAR;
    PG8_STAGE(PG8_SB(1, 0), cB + kstep, voffB); PG8_STAGE(PG8_SA(1, 0), cA + kstep, voffA); PG8_STAGE(PG8_SB(1, 1), cB + hstepB + kstep, voffB);
    PG8_WAIT_V(6); PG8_BAR;
    for (;;) {
        const bool has_next = S.next(ui + 1, nxt);
        const char* nA = has_next ? (const char*)g.A + (size_t)nxt.pm * tstepA : cA; const char* nB = has_next ? (const char*)g.Bt + (size_t)nxt.pn * tstepB : cB;
        for (int t = 0; t < nt; t += 2) {
            const bool last = (t == nt - 2);
            const char* a1 = cA + (size_t)(t + 1) * kstep;
            const char* a2 = last ? nA : cA + (size_t)(t + 2) * kstep; const char* b2 = last ? nB : cB + (size_t)(t + 2) * kstep;
            const char* a3 = a2 + kstep; const char* b3 = b2 + kstep;
            PG8_LDB(B0, 0, 0); PG8_LDB(B1, 0, 1); PG8_SCHED; PG8_LDA(At, 0, 0); PG8_STAGE(PG8_SA(1, 1), a1 + hstepA, voffA);
            PG8_WAIT_V(8); PG8_WAIT_L(0); PG8_BAR; PG8_MMA(0, 0, At, B0); PG8_MMA(0, 1, At, B1); PG8_BAR; PG8_SCHED;
            PG8_LDA(At, 0, 1); PG8_STAGE(PG8_SB(0, 0), b2, voffB); PG8_STAGE(PG8_SB(0, 1), b2 + hstepB, voffB); PG8_STAGE(PG8_SA(0, 0), a2, voffA);
            PG8_WAIT_V(8); PG8_WAIT_L(0); PG8_BAR; PG8_MMA(1, 0, At, B0); PG8_MMA(1, 1, At, B1); PG8_BAR; PG8_SCHED;
            PG8_LDB(B0, 1, 0); PG8_LDB(B1, 1, 1); PG8_SCHED; PG8_LDA(At, 1, 0); PG8_STAGE(PG8_SA(0, 1), a2 + hstepA, voffA);
            PG8_WAIT_V(8); PG8_WAIT_L(0); PG8_BAR; PG8_MMA(0, 0, At, B0); PG8_MMA(0, 1, At, B1); PG8_BAR; PG8_SCHED;
            PG8_LDA(At, 1, 1); PG8_STAGE(PG8_SB(1, 0), b3, voffB); PG8_STAGE(PG8_SB(1, 1), b3 + hstepB, voffB); PG8_STAGE(PG8_SA(1, 0), a3, voffA);
            PG8_WAIT_V(8); PG8_WAIT_L(0); PG8_BAR; PG8_MMA(1, 0, At, B0); PG8_MMA(1, 1, At, B1); PG8_BAR; PG8_SCHED;
        }
        if constexpr (ALIGN_EPI) { if (wr == 0) PG8_BAR; }
        E(acc, cur, wr, wc, fr, fq);
        if (!has_next) break;
#pragma unroll
        for (int a = 0; a < 2; ++a)
#pragma unroll
            for (int b = 0; b < 2; ++b)
#pragma unroll
                for (int m = 0; m < 4; ++m)
#pragma unroll
                    for (int n = 0; n < 2; ++n) acc[a][b][m][n] = (f32x4){0.f, 0.f, 0.f, 0.f};
        cur = nxt; cA = nA; cB = nB; ++ui;
        if constexpr (ALIGN_EPI) { if (wr == 1) PG8_BAR; }
    }
    PG8_WAIT_V(0);
    if constexpr (!ALIGN_EPI) { if (wr == 0) PG8_BAR; }
    PG8_BAR;
#undef PG8_SA
#undef PG8_SB
#undef PG8_STAGE
#undef PG8_LDA
#undef PG8_LDB
#undef PG8_MMA
#undef PG8_WAIT_V
#undef PG8_WAIT_L
#undef PG8_BAR
#undef PG8_SCHED
}

enum { EP_BF16 = 0, EP_EA = 1, EP_ATTOUT = 2, EP_RWOUT = 3, EP_RESID = 4, EP_EAH = 5 };
struct EpiArgs {
    bf16_t* o0; bf16_t* o1; int ld0, ld1, ncol0, row0g;
    const float* p0; const float* p1;
    const bf16_t* gate; float* t1; const float* base; float* outf;
};
template <int MODE> struct Epi {
    static constexpr bool PERM = (MODE == EP_BF16 || MODE == EP_EA || MODE == EP_RWOUT || MODE == EP_EAH);
    EpiArgs a;
    __device__ __forceinline__ void operator()(const f32x4 (&acc)[2][2][4][2], const Unit& u, int wr, int wc, int fr, int fq) const {
        { const int l_ = lane_id_asm(); fr = l_ & 15; fq = l_ >> 4; }
        const int row0 = u.pm * BM + wr * 64 + fr;
        if constexpr (MODE == EP_BF16) {
            int colt = u.pn * BM; bf16_t* base = a.o0; int ld = a.ld0;
            if (colt >= a.ncol0) { base = a.o1; ld = a.ld1; colt -= a.ncol0; }
            const int col0 = colt + wc * 32 + 8 * fq;
#pragma unroll
            for (int ai = 0; ai < 2; ++ai)
#pragma unroll
                for (int m = 0; m < 4; ++m) { bf16_t* rowp = base + (size_t)(row0 + ai * HALF + m * 16) * ld + col0;
#pragma unroll
                    for (int bj = 0; bj < 2; ++bj) { const f32x4 v0 = acc[ai][bj][m][0], v1 = acc[ai][bj][m][1];
                        u32x4 w; w.x = pk_bf16(v0[0], v0[1]); w.y = pk_bf16(v0[2], v0[3]); w.z = pk_bf16(v1[0], v1[1]); w.w = pk_bf16(v1[2], v1[3]);
                        *(u32x4*)(rowp + bj * HALF) = w; }
                    asm volatile("" ::: "memory"); }
        } else if constexpr (MODE == EP_EAH) {
            const int frl = fr, fql = fq;
            const int rb = u.pm * BM, bb = rb >> 12, t0 = (rb & 4095) + wr * 64 + frl;
            const int c0 = u.pn * BM + wc * 32 + 8 * fql, c1 = c0 + HALF;
            const unsigned of0 = (unsigned)(bb * 16 + ((c0 >> 6) & 15)) * 524288u + (unsigned)t0 * 128u + (unsigned)((c0 >> 10) * 64 + (c0 & 63));
            const unsigned of1 = (unsigned)(bb * 16 + ((c1 >> 6) & 15)) * 524288u + (unsigned)t0 * 128u + (unsigned)((c1 >> 10) * 64 + (c1 & 63));
#pragma unroll
            for (int ai = 0; ai < 2; ++ai)
#pragma unroll
                for (int m = 0; m < 4; ++m) {
#pragma unroll
                    for (int bj = 0; bj < 2; ++bj) { const f32x4 v0 = acc[ai][bj][m][0], v1 = acc[ai][bj][m][1];
                        u32x4 w; w.x = pk_bf16(v0[0], v0[1]); w.y = pk_bf16(v0[2], v0[3]); w.z = pk_bf16(v1[0], v1[1]); w.w = pk_bf16(v1[2], v1[3]);
                        *(u32x4*)(a.o0 + ((bj ? of1 : of0) + (unsigned)((ai * HALF + m * 16) * 128))) = w; }
                    asm volatile("" ::: "memory"); }
        } else if constexpr (MODE == EP_EA) {
            const int col0 = u.pn * BM + wc * 32 + 8 * fq;
            const bool isw = (u.pn < 4);
            const float* bias = isw ? a.p0 : (a.p1 - 1024);
            const float scl = isw ? 0.60653066f : 1.0f;
#pragma unroll
            for (int ai = 0; ai < 2; ++ai)
#pragma unroll
                for (int m = 0; m < 4; ++m) { bf16_t* rowp = a.o0 + (size_t)(row0 + ai * HALF + m * 16) * a.ld0 + col0;
#pragma unroll
                    for (int bj = 0; bj < 2; ++bj) { const f32x4 bv0 = *(const f32x4*)(bias + col0 + bj * HALF), bv1 = *(const f32x4*)(bias + col0 + bj * HALF + 4);
                        f32x4 v0 = acc[ai][bj][m][0] + bv0, v1 = acc[ai][bj][m][1] + bv1;
#pragma unroll
                        for (int j = 0; j < 4; ++j) { v0[j] = scl * sigm(v0[j]); v1[j] = scl * sigm(v1[j]); }
                        u32x4 w; w.x = pk_bf16(v0[0], v0[1]); w.y = pk_bf16(v0[2], v0[3]); w.z = pk_bf16(v1[0], v1[1]); w.w = pk_bf16(v1[2], v1[3]);
                        *(u32x4*)(rowp + bj * HALF) = w; }
                    asm volatile("" ::: "memory"); }
        } else if constexpr (MODE == EP_ATTOUT) {
            const int col0 = u.pn * BM + wc * 32 + 4 * fq;
#pragma unroll
            for (int ai = 0; ai < 2; ++ai)
#pragma unroll
                for (int m = 0; m < 4; ++m) { const size_t r = (size_t)(row0 + ai * HALF + m * 16);
#pragma unroll
                    for (int bj = 0; bj < 2; ++bj)
#pragma unroll
                        for (int n = 0; n < 2; ++n) { const int c = col0 + bj * HALF + n * 16;
                            const u32x2 gq = *(const u32x2*)(a.gate + r * 2048 + c); const f32x4 bg = *(const f32x4*)(a.p0 + c);
                            const f32x4 v = acc[ai][bj][m][n]; f32x4 o;
                            o[0] = sigm(bf_lo(gq.x) + bg[0]) * v[0]; o[1] = sigm(bf_hi(gq.x) + bg[1]) * v[1]; o[2] = sigm(bf_lo(gq.y) + bg[2]) * v[2]; o[3] = sigm(bf_hi(gq.y) + bg[3]) * v[3];
                            *(f32x4*)(a.t1 + r * 1024 + c) = o; }
                    asm volatile("" ::: "memory"); }
        } else if constexpr (MODE == EP_RWOUT) {
            const int col0 = u.pn * BM + wc * 32 + 8 * fq;
#pragma unroll
            for (int ai = 0; ai < 2; ++ai)
#pragma unroll
                for (int m = 0; m < 4; ++m) { const size_t r = (size_t)(row0 + ai * HALF + m * 16);
#pragma unroll
                    for (int bj = 0; bj < 2; ++bj) { const int c = col0 + bj * HALF;
                        const u32x4 gq = *(const u32x4*)(a.gate + r * 2048 + 1024 + c);
                        const f32x4 b0 = *(const f32x4*)(a.p0 + 1024 + c), b1 = *(const f32x4*)(a.p0 + 1024 + c + 4);
                        const f32x4 t0 = *(const f32x4*)(a.t1 + r * 1024 + c), t1v = *(const f32x4*)(a.t1 + r * 1024 + c + 4);
                        const f32x4 v0 = acc[ai][bj][m][0], v1 = acc[ai][bj][m][1]; f32x4 o0, o1;
                        o0[0] = t0[0] + sigm(bf_lo(gq.x) + b0[0]) * v0[0]; o0[1] = t0[1] + sigm(bf_hi(gq.x) + b0[1]) * v0[1];
                        o0[2] = t0[2] + sigm(bf_lo(gq.y) + b0[2]) * v0[2]; o0[3] = t0[3] + sigm(bf_hi(gq.y) + b0[3]) * v0[3];
                        o1[0] = t1v[0] + sigm(bf_lo(gq.z) + b1[0]) * v1[0]; o1[1] = t1v[1] + sigm(bf_hi(gq.z) + b1[1]) * v1[1];
                        o1[2] = t1v[2] + sigm(bf_lo(gq.w) + b1[2]) * v1[2]; o1[3] = t1v[3] + sigm(bf_hi(gq.w) + b1[3]) * v1[3];
                        u32x4 w; w.x = pk_bf16(o0[0], o0[1]); w.y = pk_bf16(o0[2], o0[3]); w.z = pk_bf16(o1[0], o1[1]); w.w = pk_bf16(o1[2], o1[3]);
                        *(u32x4*)(a.o0 + r * 1024 + c) = w; }
                    asm volatile("" ::: "memory"); }
        } else {
            const int col0 = u.pn * BM + wc * 32 + 4 * fq;
            const int bidx = (a.row0g + u.pm * BM) >> 12;
            const float* gp = a.p0 + (size_t)bidx * 6144 + col0;
#pragma unroll
            for (int ai = 0; ai < 2; ++ai)
#pragma unroll
                for (int m = 0; m < 4; ++m) { const size_t off = (size_t)(row0 + ai * HALF + m * 16) * 1024 + col0;
#pragma unroll
                    for (int bj = 0; bj < 2; ++bj)
#pragma unroll
                        for (int n = 0; n < 2; ++n) { const f32x4 bs = *(const f32x4*)(a.base + off + bj * HALF + n * 16); const f32x4 gv = *(const f32x4*)(gp + bj * HALF + n * 16);
                            *(f32x4*)(a.outf + off + bj * HALF + n * 16) = bs + gv * acc[ai][bj][m][n]; }
                    asm volatile("" ::: "memory"); }
        }
    }
};
}

#define XB_TMO      128
#define XB_XCNT(j)  (256  + 64 * (j))
#define XB_XSUB(j)  (1280 + 64 * (j))
#define XB_XGEN(j)  (2304 + 64 * (j))
#define XB_TOP      3328
#define XB_TOPGEN   3392
#define XCD_BAR_WORDS 3456
#define XB_SPIN_CAP (1u << 20)
__device__ __forceinline__ unsigned xb_ld(unsigned* p)              { return __hip_atomic_load(p, __ATOMIC_RELAXED, __HIP_MEMORY_SCOPE_AGENT); }
__device__ __forceinline__ unsigned xb_add(unsigned* p, unsigned v) { return __hip_atomic_fetch_add(p, v, __ATOMIC_RELAXED, __HIP_MEMORY_SCOPE_AGENT); }
__device__ __forceinline__ unsigned xb_xcc_id() { return (unsigned)__builtin_amdgcn_s_getreg((3 << 11) | 20) & 0xFu; }
#define XB_SPIN(cond, bar) do { unsigned _sp = 0; while (cond) { __builtin_amdgcn_s_sleep(1); \
    if ((++_sp & 255u) == 0u) { if (xb_ld(&(bar)[XB_TMO])) break; if (_sp > XB_SPIN_CAP) { atomicAdd(&(bar)[XB_TMO], 1u); break; } } } } while (0)
__device__ __forceinline__ void xcd_barrier_complete(unsigned* bar, unsigned x, unsigned& nloc, unsigned& nx) {
    const unsigned G = gridDim.x; unsigned sum, cnt, mine, sp = 0u;
    for (;;) {
        sum = 0u; cnt = 0u; mine = 0u;
#pragma unroll
        for (unsigned j = 0; j < 16; ++j) { const unsigned c = xb_ld(&bar[XB_XCNT(j)]); sum += c; cnt += (c > 0u) ? 1u : 0u; mine = (j == x) ? c : mine; }
        if (sum == G) break;
        __builtin_amdgcn_s_sleep(1);
        if ((++sp & 255u) == 0u) { if (xb_ld(&bar[XB_TMO])) break; if (sp > XB_SPIN_CAP) { atomicAdd(&bar[XB_TMO], 1u); break; } }
    }
    nloc = mine > 0u ? mine : 1u; nx = cnt > 0u ? cnt : 1u;
}
__device__ __forceinline__ void xcd_barrier(const int WV, unsigned* bar, volatile LAS unsigned* st) {
    asm volatile("s_waitcnt vmcnt(0)" ::: "memory");
    __syncthreads();
    if (ltid() == 0) {
        const unsigned x = xb_xcc_id();
        __builtin_amdgcn_s_waitcnt(0);
        unsigned nloc = st[0], nx = st[1];
        if (nloc == 0u) { xcd_barrier_complete(bar, x, nloc, nx); st[0] = nloc; st[1] = nx; }
        const unsigned old = xb_add(&bar[XB_XSUB(x)], 1u);
        const unsigned gen = old / nloc;
        if (old + 1u == (gen + 1u) * nloc) {
            __builtin_amdgcn_fence(__ATOMIC_RELEASE, "agent");
            asm volatile("s_waitcnt vmcnt(0)" ::: "memory");
            const unsigned og = xb_add(&bar[XB_TOP], 1u);
            const unsigned tg = og / nx;
            if (og + 1u == (tg + 1u) * nx) xb_add(&bar[XB_TOPGEN], 1u);
            else XB_SPIN(xb_ld(&bar[XB_TOPGEN]) == tg, bar);
            __builtin_amdgcn_fence(__ATOMIC_ACQUIRE, "agent");
            xb_add(&bar[XB_XGEN(x)], 1u);
            asm volatile("s_waitcnt vmcnt(0)" ::: "memory");
        } else {
            XB_SPIN(xb_ld(&bar[XB_XGEN(x)]) == gen, bar);
            __builtin_amdgcn_fence(__ATOMIC_ACQUIRE, "agent");
            asm volatile("s_waitcnt vmcnt(0)" ::: "memory");
        }
    }
    __syncthreads();
}

struct Args { const float* in[27]; float* out; unsigned char* ws; int ph_lo, ph_hi; };
typedef const __attribute__((address_space(4))) Args* kargs_t;
__device__ __forceinline__ kargs_t launder_args(kargs_t p) { asm volatile("" : "+s"(p)); return p; }
enum { I_X = 0, I_C, I_WADA, I_BADA, I_N1W, I_WIN, I_BGATE, I_MU, I_W0, I_W2, I_A0, I_A2, I_G2, I_KK, I_KA, I_RK, I_LNW, I_LNB, I_WATTO, I_WRWO, I_WO, I_N2W, I_WUP, I_CONVW, I_CONVB, I_WDN, I_NFW };

__device__ __forceinline__ void conv_job(const int WV, const float* src, int ldn, int c0, int K, bf16_t* dst, int ldk, int r0, int nrows, lds_t lds) {
    LAS float* tile = (LAS float*)lds;
    const int tid = ltid(), nkt = K / 64, ntiles = (nrows / 32) * nkt;
    const int kl = tid >> 3, n4 = (tid & 7) * 4, nl = tid >> 4, k4 = (tid & 15) * 4;
    int t = blockIdx.x; f32x4 vn = (f32x4){0.f, 0.f, 0.f, 0.f};
    if (t < ntiles) vn = *(const f32x4*)(src + (size_t)((t % nkt) * 64 + kl) * ldn + c0 + (t / nkt) * 32 + n4);
    for (; t < ntiles; t += gridDim.x) {
        const int n0 = (t / nkt) * 32, k0 = (t % nkt) * 64; const f32x4 v = vn;
        const int tn = t + gridDim.x;
        if (tn < ntiles) vn = *(const f32x4*)(src + (size_t)((tn % nkt) * 64 + kl) * ldn + c0 + (tn / nkt) * 32 + n4);
        tile[kl * 33 + n4 + 0] = v[0]; tile[kl * 33 + n4 + 1] = v[1]; tile[kl * 33 + n4 + 2] = v[2]; tile[kl * 33 + n4 + 3] = v[3];
        __syncthreads();
        { u32x2 w; w.x = pk_bf16(tile[(k4 + 0) * 33 + nl], tile[(k4 + 1) * 33 + nl]); w.y = pk_bf16(tile[(k4 + 2) * 33 + nl], tile[(k4 + 3) * 33 + nl]);
          *(u32x2*)(dst + (size_t)(r0 + n0 + nl) * ldk + k0 + k4) = w; }
        __syncthreads();
    }
}
__device__ __forceinline__ void p0_weights(const int WV, kargs_t A, lds_t lds) {
    unsigned char* ws = A->ws; const int tid = ltid(), G = gridDim.x; const size_t gtid = (size_t)blockIdx.x * NTHREADS + tid, gsz = (size_t)G * NTHREADS;
    conv_job(WV, A->in[I_WIN], 10016, 4608, 1024, (bf16_t*)(ws + WS_WINRW), 1024, 0, 3360, lds);
    conv_job(WV, A->in[I_WIN], 10016, 0, 1024, (bf16_t*)(ws + WS_WINAG), 1024, 0, 4608, lds);
    conv_job(WV, A->in[I_WIN], 10016, 7968, 1024, (bf16_t*)(ws + WS_WINAG), 1024, 4608, 2048, lds);
    conv_job(WV, A->in[I_WATTO], 1024, 0, 512, (bf16_t*)(ws + WS_WATTO), 512, 0, 1024, lds);
    conv_job(WV, A->in[I_WRWO], 1024, 0, 1024, (bf16_t*)(ws + WS_WRWO), 1024, 0, 1024, lds);
    conv_job(WV, A->in[I_WO], 1024, 0, 1024, (bf16_t*)(ws + WS_WO), 1024, 0, 1024, lds);
    { unsigned* z = (unsigned*)(ws + WS_WINRW + (size_t)3360 * 1024 * 2); for (size_t i = gtid; i < (size_t)224 * 512; i += gsz) z[i] = 0u; }
    { bf16_t* wl = (bf16_t*)(ws + WS_WLORA); const float* w2 = A->in[I_W2]; const float* a2 = A->in[I_A2]; const float* g2 = A->in[I_G2];
      for (size_t i = gtid; i < (size_t)384 * 3072; i += gsz) { const int k = (int)(i / 3072), n = (int)(i % 3072), seg = n >> 10, nn = n & 1023; float v = 0.f;
          if (seg == 0) { if (k < 64) v = w2[k * 1024 + nn]; } else if (seg == 1) { if (k >= 64 && k < 128) v = a2[(k - 64) * 1024 + nn]; } else { if (k >= 128 && k < 288) v = g2[(k - 128) * 1024 + nn]; }
          wl[(size_t)n * 384 + k] = f2bf(v); } }
    { float* ada = (float*)(ws + WS_ADA); const float* cc = A->in[I_C]; const float* wa = A->in[I_WADA]; const float* ba = A->in[I_BADA]; LAS float* red = (LAS float*)lds;
      for (int item = blockIdx.x; item < 192; item += G) {
          const int cl = tid & 31, ks = tid >> 5, col = item * 32 + cl; float ac[8];
#pragma unroll
          for (int b = 0; b < 8; ++b) ac[b] = 0.f;
          for (int k = ks * 64; k < ks * 64 + 64; ++k) { const float w = wa[(size_t)k * 6144 + col];
#pragma unroll
              for (int b = 0; b < 8; ++b) ac[b] = fmaf(cc[b * 1024 + k], w, ac[b]); }
#pragma unroll
          for (int b = 0; b < 8; ++b) red[(ks * 8 + b) * 32 + cl] = ac[b];
          __syncthreads();
          if (tid < 256) { const int b = tid >> 5; float s = 0.f;
#pragma unroll
              for (int q = 0; q < 16; ++q) s += red[(q * 8 + b) * 32 + cl];
              ada[b * 6144 + col] = s + ba[col]; }
          __syncthreads();
      } }
}

__device__ __forceinline__ void p_ffn_weights(const int WV, kargs_t A, lds_t lds) {
    unsigned char* ws = A->ws;
    conv_job(WV, A->in[I_WUP], 5632, 0, 1024, (bf16_t*)(ws + WS_WUP), 1024, 0, 5632, lds);
    conv_job(WV, A->in[I_WDN], 1024, 0, 2816, (bf16_t*)(ws + WS_WDN), 2816, 0, 1024, lds);
}
template <bool ADA, bool OUTBF>
__device__ __forceinline__ void norm_rows(const int WV, const float* src, const float* w, const float* ada_sh, const float* ada_sc, void* dst, int nrows, int row0g) {
    const int tid_ = ltid(); const int lane = tid_ & 63, wid = tid_ >> 6;
    const int nw = gridDim.x * 8, gw = blockIdx.x * 8 + wid;
    const int per = (nrows + nw - 1) / nw, r_begin = gw * per, r_end = (r_begin + per < nrows) ? r_begin + per : nrows;
    f32x4 cw[4], cs[4], vn[4]; int cb = -1;
    if (r_begin < r_end) {
#pragma unroll
        for (int i = 0; i < 4; ++i) vn[i] = *(const f32x4*)(src + (size_t)r_begin * 1024 + 4 * (lane + 64 * i)); }
    for (int r = r_begin; r < r_end; ++r) {
        const int b = (row0g + r) >> 12;
        if (b != cb) { cb = b;
#pragma unroll
            for (int i = 0; i < 4; ++i) { const int c = 4 * (lane + 64 * i); cw[i] = *(const f32x4*)(w + c);
                if constexpr (ADA) { const f32x4 sc = *(const f32x4*)(ada_sc + (size_t)b * 6144 + c); cw[i] = cw[i] * (sc + 1.0f); cs[i] = *(const f32x4*)(ada_sh + (size_t)b * 6144 + c); } } }
        f32x4 v[4]; float ss = 0.f;
#pragma unroll
        for (int i = 0; i < 4; ++i) v[i] = vn[i];
        if (r + 1 < r_end) { const float* pn = src + (size_t)(r + 1) * 1024;
#pragma unroll
            for (int i = 0; i < 4; ++i) vn[i] = *(const f32x4*)(pn + 4 * (lane + 64 * i)); }
#pragma unroll
        for (int i = 0; i < 4; ++i) ss += v[i][0] * v[i][0] + v[i][1] * v[i][1] + v[i][2] * v[i][2] + v[i][3] * v[i][3];
#pragma unroll
        for (int o = 32; o >= 1; o >>= 1) ss += __shfl_xor(ss, o);
        const float rs = rsqrtf(ss * (1.0f / 1024.0f) + 1e-6f);
#pragma unroll
        for (int i = 0; i < 4; ++i) { const int c = 4 * (lane + 64 * i); f32x4 y = v[i] * rs * cw[i];
            if constexpr (ADA) y = y + cs[i];
            if constexpr (OUTBF) { u32x2 o; o.x = pk_bf16(y[0], y[1]); o.y = pk_bf16(y[2], y[3]); *(u32x2*)((bf16_t*)dst + (size_t)r * 1024 + c) = o; }
            else *(f32x4*)((float*)dst + (size_t)r * 1024 + c) = y; }
    }
}

__device__ __forceinline__ void lora_prep(const int WV, kargs_t A) {
    const bf16_t* prw = (const bf16_t*)(A->ws + WS_PRW); bf16_t* al = (bf16_t*)(A->ws + WS_ALORA); const float* mu = A->in[I_MU] + 3072;
    const size_t gtid = (size_t)blockIdx.x * NTHREADS + ltid(), gsz = (size_t)gridDim.x * NTHREADS;
    for (size_t it = gtid; it < (size_t)MTOK * 48; it += gsz) {
        const int row = (int)(it / 48), ch = (int)(it % 48); u32x4 o = (u32x4){0u, 0u, 0u, 0u};
        if (ch < 36) {
            const bf16_t* p = prw + (size_t)row * NRW + 3072 + ch * 8;
            const u32x4 cu = *(const u32x4*)p; u32x4 pv = (u32x4){0u, 0u, 0u, 0u}; if ((row & 4095) != 0) pv = *(const u32x4*)(p - NRW);
            const f32x4 m0 = *(const f32x4*)(mu + ch * 8), m1 = *(const f32x4*)(mu + ch * 8 + 4);
            float z[8], zp[8];
            z[0] = bf_lo(cu.x); z[1] = bf_hi(cu.x); z[2] = bf_lo(cu.y); z[3] = bf_hi(cu.y); z[4] = bf_lo(cu.z); z[5] = bf_hi(cu.z); z[6] = bf_lo(cu.w); z[7] = bf_hi(cu.w);
            zp[0] = bf_lo(pv.x); zp[1] = bf_hi(pv.x); zp[2] = bf_lo(pv.y); zp[3] = bf_hi(pv.y); zp[4] = bf_lo(pv.z); zp[5] = bf_hi(pv.z); zp[6] = bf_lo(pv.w); zp[7] = bf_hi(pv.w);
#pragma unroll
            for (int j = 0; j < 8; ++j) { const float m = j < 4 ? m0[j & 3] : m1[j & 3]; float s = z[j] + (zp[j] - z[j]) * m;
                if (ch < 8) s = tanhf(s); else if (ch >= 16) s = sigm(s);
                z[j] = s; }
            o.x = pk_bf16(z[0], z[1]); o.y = pk_bf16(z[2], z[3]); o.z = pk_bf16(z[4], z[5]); o.w = pk_bf16(z[6], z[7]);
        }
        *(u32x4*)(al + (size_t)row * 384 + ch * 8) = o;
    }
}

__device__ __forceinline__ float allred8(float x) { x += dppf<0xB1>(x); x += dppf<0x4E>(x); x += dppf<0x141>(x); return x; }
__device__ __forceinline__ void scan_phase(const int WV, kargs_t A, lds_t lds) {
    const bf16_t* prw = (const bf16_t*)(A->ws + WS_PRW); const bf16_t* ea = (const bf16_t*)(A->ws + WS_EA);
    bf16_t* Y = (bf16_t*)(A->ws + WS_Y); float* BS = (float*)(A->ws + WS_BS);
    LAS float* L = (LAS float*)lds;
    LAS float* SY = L + 22528;
    const int tid = ltid(); const bool scanw = (WV < 4);
    const int ltd = tid & 255, r8 = ltd >> 3, k8 = ltd & 7;
    for (int item = blockIdx.x; item < 256; item += gridDim.x) {
        const int half = (item >> 3) & 1, pair = ((item >> 4) << 3) | (item & 7), h = pair & 15, b = pair >> 4;
        const int cr = h * 64 + 8 * k8, cv = h * 64 + half * 32 + 4 * k8;
        f32x4 cmur[2], cmuk[2], ckkv[2], ckav[2], crkv[2];
#pragma unroll
        for (int q = 0; q < 2; ++q) { cmur[q] = *(const f32x4*)(A->in[I_MU] + cr + 4 * q); cmuk[q] = *(const f32x4*)(A->in[I_MU] + 1024 + cr + 4 * q);
            ckkv[q] = *(const f32x4*)(A->in[I_KK] + cr + 4 * q); ckav[q] = *(const f32x4*)(A->in[I_KA] + cr + 4 * q); crkv[q] = *(const f32x4*)(A->in[I_RK] + cr + 4 * q); }
        const f32x4 cmuv = *(const f32x4*)(A->in[I_MU] + 2048 + cv);
        auto produce = [&](const int cc, const int bufi) {
            const int t = cc * 32 + r8; const size_t row = (size_t)b * SEQ + t; const bf16_t* pr = prw + row * NRW; const bf16_t* pp = (t > 0) ? pr - NRW : pr;
            const u32x4 ur = *(const u32x4*)(pr + cr), uk = *(const u32x4*)(pr + 1024 + cr); u32x4 urp = *(const u32x4*)(pp + cr), ukp = *(const u32x4*)(pp + 1024 + cr);
            const u32x2 uv = *(const u32x2*)(pr + 2048 + cv); u32x2 uvp = *(const u32x2*)(pp + 2048 + cv);
            const u32x4 ue = *(const u32x4*)(ea + row * 2048 + cr), ua = *(const u32x4*)(ea + row * 2048 + 1024 + cr);
            if (t == 0) { urp = (u32x4){0u, 0u, 0u, 0u}; ukp = (u32x4){0u, 0u, 0u, 0u}; uvp = (u32x2){0u, 0u}; }
            const float zr[8] = {bf_lo(ur.x), bf_hi(ur.x), bf_lo(ur.y), bf_hi(ur.y), bf_lo(ur.z), bf_hi(ur.z), bf_lo(ur.w), bf_hi(ur.w)};
            const float zrp[8] = {bf_lo(urp.x), bf_hi(urp.x), bf_lo(urp.y), bf_hi(urp.y), bf_lo(urp.z), bf_hi(urp.z), bf_lo(urp.w), bf_hi(urp.w)};
            const float zk[8] = {bf_lo(uk.x), bf_hi(uk.x), bf_lo(uk.y), bf_hi(uk.y), bf_lo(uk.z), bf_hi(uk.z), bf_lo(uk.w), bf_hi(uk.w)};
            const float zkp[8] = {bf_lo(ukp.x), bf_hi(ukp.x), bf_lo(ukp.y), bf_hi(ukp.y), bf_lo(ukp.z), bf_hi(ukp.z), bf_lo(ukp.w), bf_hi(ukp.w)};
            const float ze[8] = {bf_lo(ue.x), bf_hi(ue.x), bf_lo(ue.y), bf_hi(ue.y), bf_lo(ue.z), bf_hi(ue.z), bf_lo(ue.w), bf_hi(ue.w)};
            const float za[8] = {bf_lo(ua.x), bf_hi(ua.x), bf_lo(ua.y), bf_hi(ua.y), bf_lo(ua.z), bf_hi(ua.z), bf_lo(ua.w), bf_hi(ua.w)};
            float r_[8], k_[8], e_[8], a_[8], kk_[8]; float n2 = 0.f;
#pragma unroll
            for (int i = 0; i < 8; ++i) {
                r_[i] = zr[i] + (zrp[i] - zr[i]) * cmur[i >> 2][i & 3]; k_[i] = zk[i] + (zkp[i] - zk[i]) * cmuk[i >> 2][i & 3];
                e_[i] = ze[i]; a_[i] = za[i];
                kk_[i] = k_[i] * ckkv[i >> 2][i & 3]; n2 = fmaf(kk_[i], kk_[i], n2); }
            n2 = allred8(n2); const float inv = __builtin_amdgcn_rcpf(fmaxf(__builtin_amdgcn_sqrtf(n2), 1e-12f));
            float o_r[8], o_w[8], o_k[8], o_a[8], o_b[8]; float bsum = 0.f;
#pragma unroll
            for (int i = 0; i < 8; ++i) { const float kn = kk_[i] * inv; const float km = k_[i] * (1.0f + (a_[i] - 1.0f) * ckav[i >> 2][i & 3]);
                o_r[i] = r_[i]; o_w[i] = __expf(-e_[i]); o_k[i] = km; o_a[i] = -kn; o_b[i] = kn * a_[i]; bsum = fmaf(r_[i] * km, crkv[i >> 2][i & 3], bsum); }
            bsum = allred8(bsum);
            LAS float* Bf = L + bufi * 11264 + r8 * 64 + 8 * k8;
#pragma unroll
            for (int q = 0; q < 2; ++q) {
                *(LAS f32x4*)(Bf + 4 * q) = (f32x4){o_r[4 * q], o_r[4 * q + 1], o_r[4 * q + 2], o_r[4 * q + 3]};
                *(LAS f32x4*)(Bf + 2048 + 4 * q) = (f32x4){o_w[4 * q], o_w[4 * q + 1], o_w[4 * q + 2], o_w[4 * q + 3]};
                *(LAS f32x4*)(Bf + 4096 + 4 * q) = (f32x4){o_k[4 * q], o_k[4 * q + 1], o_k[4 * q + 2], o_k[4 * q + 3]};
                *(LAS f32x4*)(Bf + 6144 + 4 * q) = (f32x4){o_a[4 * q], o_a[4 * q + 1], o_a[4 * q + 2], o_a[4 * q + 3]};
                *(LAS f32x4*)(Bf + 8192 + 4 * q) = (f32x4){o_b[4 * q], o_b[4 * q + 1], o_b[4 * q + 2], o_b[4 * q + 3]}; }
            { const float v0 = bf_lo(uv.x), v1 = bf_hi(uv.x), v2 = bf_lo(uv.y), v3 = bf_hi(uv.y);
              *(LAS f32x4*)(L + bufi * 11264 + 10240 + r8 * 32 + 4 * k8) = (f32x4){v0 + (bf_lo(uvp.x) - v0) * cmuv[0], v1 + (bf_hi(uvp.x) - v1) * cmuv[1], v2 + (bf_lo(uvp.y) - v2) * cmuv[2], v3 + (bf_hi(uvp.y) - v3) * cmuv[3]}; }
            if (half == 0 && k8 == 0) BS[row * 16 + h] = bsum;
        };
        auto ystore = [&](const int cc) {
            const LAS float* syr = SY + (cc % 3) * 1024 + r8 * 32 + 4 * k8; const f32x4 yv = *(const LAS f32x4*)syr;
            u32x2 w; w.x = pk_bf16(yv[0], yv[1]); w.y = pk_bf16(yv[2], yv[3]);
            *(u32x2*)(Y + ((size_t)(b * 16 + h) * 4096 + cc * 32 + r8) * 64 + half * 32 + 4 * k8) = w;
        };
        __syncthreads();
        if (!scanw) produce(0, 0);
        __syncthreads();
        f32x2 S0 = {0.f, 0.f}, S1 = {0.f, 0.f}, S2 = {0.f, 0.f}, S3 = {0.f, 0.f};
        float yq = 0.f, yreg = 0.f;
        struct StepIn { f32x4 r0, r1, w0, w1, k0, k1, a0, a1, b0, b1; float v; };
#define SCAN_LDS(R, t) do { const unsigned ab_ = (unsigned)(size_t)(Bc + (t) * 64 + 8 * k8), av_ = (unsigned)(size_t)(Bc + (t) * 32 + r8); \
            asm volatile("ds_read_b128 %0, %11 offset:24576\n\tds_read_b128 %1, %11 offset:24592\n\tds_read_b128 %2, %11 offset:32768\n\tds_read_b128 %3, %11 offset:32784\n\t" \
                         "ds_read_b32 %10, %12 offset:40960\n\tds_read_b128 %4, %11 offset:16384\n\tds_read_b128 %5, %11 offset:16400\n\t" \
                         "ds_read_b128 %6, %11 offset:8192\n\tds_read_b128 %7, %11 offset:8208\n\tds_read_b128 %8, %11\n\tds_read_b128 %9, %11 offset:16" \
                         : "=&v"(R.a0), "=&v"(R.a1), "=&v"(R.b0), "=&v"(R.b1), "=&v"(R.k0), "=&v"(R.k1), "=&v"(R.w0), "=&v"(R.w1), "=&v"(R.r0), "=&v"(R.r1), "=&v"(R.v) : "v"(ab_), "v"(av_) : "memory"); } while (0)
#define SCAN_WAIT(R) asm volatile("s_waitcnt lgkmcnt(11)" : "+v"(R.a0), "+v"(R.a1), "+v"(R.b0), "+v"(R.b1), "+v"(R.k0), "+v"(R.k1), "+v"(R.w0), "+v"(R.w1), "+v"(R.r0), "+v"(R.r1), "+v"(R.v) :: "memory")
#define P2(v4, i) ((f32x2){v4[2 * (i)], v4[2 * (i) + 1]})
#define SCAN_STEP(R, t) do { \
            f32x2 pa = S0 * P2(R.a0, 0), pb = S1 * P2(R.a0, 1); pa = S2 * P2(R.a1, 0) + pa; pb = S3 * P2(R.a1, 1) + pb; \
            float sa = (pa.x + pb.x) + (pa.y + pb.y); float yy = yq; \
            sa += dppf<0xB1>(sa); yy += dppf<0xB1>(yy); sa += dppf<0x4E>(sa); yy += dppf<0x4E>(yy); sa += dppf<0x141>(sa); yy += dppf<0x141>(yy); \
            yreg = (k8 == (((t) + 7) & 7)) ? yy : yreg; \
            const f32x2 sa2 = {sa, sa}, vv2 = {R.v, R.v}; \
            f32x2 t0 = vv2 * P2(R.k0, 0), t1 = vv2 * P2(R.k0, 1), t2 = vv2 * P2(R.k1, 0), t3 = vv2 * P2(R.k1, 1); \
            t0 = sa2 * P2(R.b0, 0) + t0; t1 = sa2 * P2(R.b0, 1) + t1; t2 = sa2 * P2(R.b1, 0) + t2; t3 = sa2 * P2(R.b1, 1) + t3; \
            S0 = S0 * P2(R.w0, 0) + t0; S1 = S1 * P2(R.w0, 1) + t1; S2 = S2 * P2(R.w1, 0) + t2; S3 = S3 * P2(R.w1, 1) + t3; \
            f32x2 qa = S0 * P2(R.r0, 0); qa = S1 * P2(R.r0, 1) + qa; qa = S2 * P2(R.r1, 0) + qa; qa = S3 * P2(R.r1, 1) + qa; \
            yq = qa.x + qa.y; } while (0)
        for (int c = 0; c < 128; ++c) {
            if (scanw) {
                const LAS float* Bc = L + (c & 1) * 11264;
                LAS float* syc = SY + (c % 3) * 1024; LAS float* syp = SY + ((c + 2) % 3) * 1024;
                StepIn R0, R1;
                SCAN_LDS(R0, 0);
#pragma unroll 4
                for (int t = 0; t < 32; t += 2) {
                    SCAN_LDS(R1, t + 1); SCAN_WAIT(R0); SCAN_STEP(R0, t);
                    if ((t & 7) == 0) { if (t == 0) { if (c > 0) syp[(24 + k8) * 32 + r8] = yreg; } else syc[(t - 8 + k8) * 32 + r8] = yreg; }
                    SCAN_LDS(R0, (t + 2) & 31); SCAN_WAIT(R1); SCAN_STEP(R1, t + 1);
                }
                asm volatile("s_waitcnt lgkmcnt(0)" : "+v"(R0.a0), "+v"(R0.a1), "+v"(R0.b0), "+v"(R0.b1), "+v"(R0.k0), "+v"(R0.k1), "+v"(R0.w0), "+v"(R0.w1), "+v"(R0.r0), "+v"(R0.r1), "+v"(R0.v) :: "memory");
            } else {
                if (c >= 2) ystore(c - 2);
                if (c + 1 < 128) produce(c + 1, (c + 1) & 1);
            }
            __syncthreads();
        }
        if (scanw) { const float yy = allred8(yq); yreg = (k8 == 7) ? yy : yreg; SY[(127 % 3) * 1024 + (24 + k8) * 32 + r8] = yreg; }
        __syncthreads();
        if (!scanw) { ystore(126); ystore(127); }
#undef SCAN_LDS
#undef SCAN_STEP
#undef P2
    }
}

__device__ __forceinline__ void post_phase(const int WV, kargs_t A) {
    const bf16_t* prw = (const bf16_t*)(A->ws + WS_PRW); const bf16_t* Y = (const bf16_t*)(A->ws + WS_Y); const bf16_t* Gg = (const bf16_t*)(A->ws + WS_G);
    const float* BS = (const float*)(A->ws + WS_BS); bf16_t* RWO = (bf16_t*)(A->ws + WS_RWO);
    const size_t gtid = (size_t)blockIdx.x * NTHREADS + ltid(), gsz = (size_t)gridDim.x * NTHREADS;
    constexpr int RR = 64;
    for (size_t it = gtid; it < (size_t)(MTOK / RR) * 256; it += gsz) {
        const int cg = (int)(it & 255), h = cg >> 4, kq = cg & 15, c = 4 * cg; const size_t row0 = (it >> 8) * RR; const int b = (int)(row0 >> 12), t0 = (int)(row0 & 4095);
        const f32x4 muv = *(const f32x4*)(A->in[I_MU] + 2048 + c), lw = *(const f32x4*)(A->in[I_LNW] + c), lb = *(const f32x4*)(A->in[I_LNB] + c);
        const bf16_t* yp = Y + ((size_t)(b * 16 + h) * 4096 + t0) * 64 + 4 * kq;
        u32x2 vp = (u32x2){0u, 0u}; if (t0 != 0) vp = *(const u32x2*)(prw + (row0 - 1) * NRW + 2048 + c);
#pragma unroll 4
        for (int rr = 0; rr < RR; ++rr) {
            const size_t row = row0 + rr;
            const u32x2 yu = *(const u32x2*)(yp + (size_t)rr * 64); const u32x2 vu = *(const u32x2*)(prw + row * NRW + 2048 + c);
            const u32x2 gu = *(const u32x2*)(Gg + row * 1024 + c); const float bs = BS[row * 16 + h];
            float y[4] = {bf_lo(yu.x), bf_hi(yu.x), bf_lo(yu.y), bf_hi(yu.y)};
            const float mean = allred16((y[0] + y[1]) + (y[2] + y[3])) * (1.0f / 64.0f);
            float q = 0.f;
#pragma unroll
            for (int i = 0; i < 4; ++i) { y[i] -= mean; q = fmaf(y[i], y[i], q); }
            const float rstd = rsqrtf(allred16(q) * (1.0f / 64.0f) + 64e-5f);
            const float vc[4] = {bf_lo(vu.x), bf_hi(vu.x), bf_lo(vu.y), bf_hi(vu.y)}, vq[4] = {bf_lo(vp.x), bf_hi(vp.x), bf_lo(vp.y), bf_hi(vp.y)}, gg[4] = {bf_lo(gu.x), bf_hi(gu.x), bf_lo(gu.y), bf_hi(gu.y)};
            float o[4];
#pragma unroll
            for (int i = 0; i < 4; ++i) { const float v = vc[i] + (vq[i] - vc[i]) * muv[i]; o[i] = (y[i] * rstd * lw[i] + lb[i] + bs * v) * gg[i]; }
            u32x2 w; w.x = pk_bf16(o[0], o[1]); w.y = pk_bf16(o[2], o[3]); *(u32x2*)(RWO + row * 1024 + c) = w;
            vp = vu;
        }
    }
}

__device__ __forceinline__ void attn_phase(const int WV, kargs_t A, lds_t lds) {
    const bf16_t* PATT = (const bf16_t*)(A->ws + WS_PATT); bf16_t* ATTO = (bf16_t*)(A->ws + WS_ATTO); float* LSE = (float*)(A->ws + WS_LSE);
    lds_t Ks = lds; lds_t Vt = lds + 36864;
    const int tid = ltid(), wid = tid >> 6, lane = tid & 63, fr = lane & 15, fq = lane >> 4, T0 = wid & ~1;
    u32x4 pk_[4], pv_[4]; bf16x8 pq_[2];
#define ATT_DECODE(u) const int idx = (u) & 31, h = ((u) >> 5) & 7, gb = (u) >> 8, g = gb % 3, bl = gb / 3; \
        const int dl = (g == 0) ? 0 : (g == 1 ? 2 : 4); const int r = idx & ((1 << dl) - 1), n = idx >> dl; \
        const bf16_t* base = PATT + (size_t)(bl * SEQ) * 4608 + g * 1536 + h * 64;
#define ATT_LOAD(u) do { ATT_DECODE(u) \
        _Pragma("unroll") for (int i = 0; i < 4; ++i) { const int c = tid + 512 * i, key = c >> 3, part = c & 7; int j = 128 * n - 128 + key; j = j < 0 ? 0 : j; const size_t pos = ((size_t)j << dl) + r; \
            pk_[i] = *(const u32x4*)(base + pos * 4608 + 512 + part * 8); pv_[i] = *(const u32x4*)(base + pos * 4608 + 1024 + part * 8); } \
        { const int qi_ = 16 * wid + fr; const size_t pos = ((size_t)(128 * n + qi_) << dl) + r; pq_[0] = *(const bf16x8*)(base + pos * 4608 + fq * 8); pq_[1] = *(const bf16x8*)(base + pos * 4608 + 32 + fq * 8); } } while (0)
    if ((int)blockIdx.x < 3072) ATT_LOAD((int)blockIdx.x);
    for (int u = blockIdx.x; u < 3072; u += gridDim.x) {
        ATT_DECODE(u) (void)base;
        __syncthreads();
#pragma unroll
        for (int i = 0; i < 4; ++i) { const int c = tid + 512 * i, key = c >> 3, part = c & 7;
            *(LAS u32x4*)(Ks + key * 144 + part * 16) = pk_[i];
            *(LAS u32x4*)(Vt + key * 144 + part * 16) = pv_[i]; }
        const int qi = 16 * wid + fr; bf16x8 qf[2]; qf[0] = pq_[0]; qf[1] = pq_[1];
        __syncthreads();
        if (u + (int)gridDim.x < 3072) ATT_LOAD(u + (int)gridDim.x);
        f32x4 st[10]; float m = -INFINITY;
#pragma unroll
        for (int T = 0; T < 10; ++T) { const int Tt = T0 + T;
            const bf16x8 k0 = *(const LAS bf16x8*)(Ks + (16 * Tt + fr) * 144 + fq * 16), k1 = *(const LAS bf16x8*)(Ks + (16 * Tt + fr) * 144 + 64 + fq * 16);
            f32x4 acc = (f32x4){0.f, 0.f, 0.f, 0.f};
            acc = __builtin_amdgcn_mfma_f32_16x16x32_bf16(k0, qf[0], acc, 0, 0, 0); acc = __builtin_amdgcn_mfma_f32_16x16x32_bf16(k1, qf[1], acc, 0, 0, 0);
            const int rel = Tt - wid;
            if (rel < 0 || rel > 8 || (n == 0 && Tt < 8)) { acc = (f32x4){-INFINITY, -INFINITY, -INFINITY, -INFINITY}; }
            else if (rel == 0) {
#pragma unroll
                for (int rg = 0; rg < 4; ++rg) { const float s = (4 * fq + rg >= fr) ? acc[rg] * 0.125f : -INFINITY; acc[rg] = s; m = fmaxf(m, s); } }
            else if (rel == 8) {
#pragma unroll
                for (int rg = 0; rg < 4; ++rg) { const float s = (4 * fq + rg <= fr) ? acc[rg] * 0.125f : -INFINITY; acc[rg] = s; m = fmaxf(m, s); } }
            else {
#pragma unroll
                for (int rg = 0; rg < 4; ++rg) { const float s = acc[rg] * 0.125f; acc[rg] = s; m = fmaxf(m, s); } }
            st[T] = acc; }
        m = fmaxf(m, __shfl_xor(m, 16)); m = fmaxf(m, __shfl_xor(m, 32));
        float den = 0.f;
#pragma unroll
        for (int T = 0; T < 10; ++T)
#pragma unroll
            for (int rg = 0; rg < 4; ++rg) { const float p = __expf(st[T][rg] - m); st[T][rg] = p; den += p; }
        den += __shfl_xor(den, 16); den += __shfl_xor(den, 32);
        f32x4 o[4];
#pragma unroll
        for (int nt = 0; nt < 4; ++nt) o[nt] = (f32x4){0.f, 0.f, 0.f, 0.f};
        const unsigned vaddr = (unsigned)(size_t)Vt + (unsigned)((4 * fq + (fr >> 2)) * 144 + (fr & 3) * 8);
#pragma unroll
        for (int s2 = 0; s2 < 5; ++s2) { const int Ta = T0 + 2 * s2;
            u32x4 pw; pw.x = pk_bf16(st[2 * s2][0], st[2 * s2][1]); pw.y = pk_bf16(st[2 * s2][2], st[2 * s2][3]); pw.z = pk_bf16(st[2 * s2 + 1][0], st[2 * s2 + 1][1]); pw.w = pk_bf16(st[2 * s2 + 1][2], st[2 * s2 + 1][3]);
            const bf16x8 pa = __builtin_bit_cast(bf16x8, pw);
            const unsigned va = vaddr + (unsigned)(16 * Ta * 144);
            u32x2 a0, a1, a2, a3, b0, b1, b2, b3;
            asm volatile("ds_read_b64_tr_b16 %0, %8\n\tds_read_b64_tr_b16 %1, %8 offset:32\n\tds_read_b64_tr_b16 %2, %8 offset:64\n\tds_read_b64_tr_b16 %3, %8 offset:96\n\t"
                         "ds_read_b64_tr_b16 %4, %8 offset:2304\n\tds_read_b64_tr_b16 %5, %8 offset:2336\n\tds_read_b64_tr_b16 %6, %8 offset:2368\n\tds_read_b64_tr_b16 %7, %8 offset:2400\n\t"
                         "s_waitcnt lgkmcnt(0)"
                         : "=&v"(a0), "=&v"(a1), "=&v"(a2), "=&v"(a3), "=&v"(b0), "=&v"(b1), "=&v"(b2), "=&v"(b3) : "v"(va) : "memory");
            { u32x4 vw; vw.x = a0.x; vw.y = a0.y; vw.z = b0.x; vw.w = b0.y; o[0] = __builtin_amdgcn_mfma_f32_16x16x32_bf16(pa, __builtin_bit_cast(bf16x8, vw), o[0], 0, 0, 0); }
            { u32x4 vw; vw.x = a1.x; vw.y = a1.y; vw.z = b1.x; vw.w = b1.y; o[1] = __builtin_amdgcn_mfma_f32_16x16x32_bf16(pa, __builtin_bit_cast(bf16x8, vw), o[1], 0, 0, 0); }
            { u32x4 vw; vw.x = a2.x; vw.y = a2.y; vw.z = b2.x; vw.w = b2.y; o[2] = __builtin_amdgcn_mfma_f32_16x16x32_bf16(pa, __builtin_bit_cast(bf16x8, vw), o[2], 0, 0, 0); }
            { u32x4 vw; vw.x = a3.x; vw.y = a3.y; vw.z = b3.x; vw.w = b3.y; o[3] = __builtin_amdgcn_mfma_f32_16x16x32_bf16(pa, __builtin_bit_cast(bf16x8, vw), o[3], 0, 0, 0); } }
        const float inv = __builtin_amdgcn_rcpf(den);
        if (fq == 0) { const size_t pos = ((size_t)(128 * n + qi) << dl) + r; LSE[((size_t)g * CH + (size_t)bl * SEQ + pos) * 8 + h] = m + __logf(den); }
#pragma unroll
        for (int rg = 0; rg < 4; ++rg) { const float iv = __shfl(inv, 4 * fq + rg); const int q = 16 * wid + 4 * fq + rg; const size_t pos = ((size_t)(128 * n + q) << dl) + r;
            bf16_t* op = ATTO + ((size_t)g * CH + (size_t)bl * SEQ + pos) * 512 + h * 64 + fr;
#pragma unroll
            for (int nt = 0; nt < 4; ++nt) op[16 * nt] = f2bf(o[nt][rg] * iv); }
    }
#undef ATT_DECODE
#undef ATT_LOAD
}

__device__ __forceinline__ void combine_phase(const int WV, kargs_t A, const size_t roff) {
    const bf16_t* ATTO = (const bf16_t*)(A->ws + WS_ATTO); const float* LSE = (const float*)(A->ws + WS_LSE); bf16_t* ATTM = (bf16_t*)(A->ws + WS_ATTM) + roff * 512;
    const size_t gtid = (size_t)blockIdx.x * NTHREADS + ltid(), gsz = (size_t)gridDim.x * NTHREADS;
    for (size_t it = gtid; it < (size_t)CH * 64; it += gsz) {
        const size_t row = it >> 6; const int ch = (int)(it & 63), h = ch >> 3;
        const float l0 = LSE[(0 * (size_t)CH + row) * 8 + h], l1 = LSE[(1 * (size_t)CH + row) * 8 + h], l2 = LSE[(2 * (size_t)CH + row) * 8 + h];
        const float mx = fmaxf(l0, fmaxf(l1, l2)); float w0 = __expf(l0 - mx), w1 = __expf(l1 - mx), w2 = __expf(l2 - mx); const float is = __builtin_amdgcn_rcpf(w0 + w1 + w2); w0 *= is; w1 *= is; w2 *= is;
        const u32x4 a0 = *(const u32x4*)(ATTO + (0 * (size_t)CH + row) * 512 + ch * 8), a1 = *(const u32x4*)(ATTO + (1 * (size_t)CH + row) * 512 + ch * 8), a2 = *(const u32x4*)(ATTO + (2 * (size_t)CH + row) * 512 + ch * 8);
        u32x4 o;
        o.x = pk_bf16(w0 * bf_lo(a0.x) + w1 * bf_lo(a1.x) + w2 * bf_lo(a2.x), w0 * bf_hi(a0.x) + w1 * bf_hi(a1.x) + w2 * bf_hi(a2.x));
        o.y = pk_bf16(w0 * bf_lo(a0.y) + w1 * bf_lo(a1.y) + w2 * bf_lo(a2.y), w0 * bf_hi(a0.y) + w1 * bf_hi(a1.y) + w2 * bf_hi(a2.y));
        o.z = pk_bf16(w0 * bf_lo(a0.z) + w1 * bf_lo(a1.z) + w2 * bf_lo(a2.z), w0 * bf_hi(a0.z) + w1 * bf_hi(a1.z) + w2 * bf_hi(a2.z));
        o.w = pk_bf16(w0 * bf_lo(a0.w) + w1 * bf_lo(a1.w) + w2 * bf_lo(a2.w), w0 * bf_hi(a0.w) + w1 * bf_hi(a1.w) + w2 * bf_hi(a2.w));
        *(u32x4*)(ATTM + row * 512 + ch * 8) = o;
    }
}

constexpr int CONV_RS = 32;
__device__ __forceinline__ void halo_phase(const int WV, kargs_t A) {
    const bf16_t* U = (const bf16_t*)(A->ws + WS_U); bf16_t* HALO = (bf16_t*)(A->ws + WS_HALO);
    const size_t gtid = (size_t)blockIdx.x * NTHREADS + ltid(), gsz = (size_t)gridDim.x * NTHREADS;
    for (size_t it = gtid; it < (size_t)(MTOK / CONV_RS) * 2 * 704; it += gsz) {
        const int ch = (int)(it % 704); const size_t sr = it / 704; const int which = (int)(sr & 1); const size_t seg = sr >> 1; const size_t row0 = seg * CONV_RS;
        u32x4 v = (u32x4){0u, 0u, 0u, 0u};
        if ((row0 & 4095) != 0) v = *(const u32x4*)(U + (row0 - 1 - which) * 5632 + ch * 8);
        *(u32x4*)(HALO + (seg * 2 + which) * 5632 + ch * 8) = v;
    }
}
__device__ __forceinline__ void conv_phase(const int WV, kargs_t A, unsigned* bar, volatile LAS unsigned* bst, const bool one_launch) {
    bf16_t* U = (bf16_t*)(A->ws + WS_U); bf16_t* HALO = (bf16_t*)(A->ws + WS_HALO); const float* cw = A->in[I_CONVW]; const float* cb = A->in[I_CONVB];
    const size_t gtid = (size_t)blockIdx.x * NTHREADS + ltid(), gsz = (size_t)gridDim.x * NTHREADS;
    constexpr int R = CONV_RS; constexpr int MAXIT = 3;
    const size_t nitems = (size_t)(MTOK / R) * 352;
    const bool fits = nitems <= (size_t)MAXIT * gsz;
    if (one_launch && !fits) {
        for (size_t it = gtid; it < (size_t)(MTOK / R) * 2 * 704; it += gsz) { const int ch = (int)(it % 704); const size_t sr = it / 704; const int which = (int)(sr & 1); const size_t seg = sr >> 1; const size_t row0 = seg * R;
            u32x4 v = (u32x4){0u, 0u, 0u, 0u}; if ((row0 & 4095) != 0) v = *(const u32x4*)(U + (row0 - 1 - which) * 5632 + ch * 8);
            *(u32x4*)(HALO + (seg * 2 + which) * 5632 + ch * 8) = v; }
        xcd_barrier(WV, bar, bst);
    }
    const bool from_u = one_launch && fits;
    auto process = [&](const size_t it, const u32x4 (&hh1)[2], const u32x4 (&hh2)[2]) {
        const size_t seg = it / 352; const int j = (int)(it % 352) * 8; const size_t row0 = seg * R;
        f32x4 wb[2][2], w0[2][2], w1[2][2], w2[2][2];
#pragma unroll
        for (int s2 = 0; s2 < 2; ++s2)
#pragma unroll
            for (int q = 0; q < 2; ++q) { const int c = s2 * DFF + j + 4 * q; wb[s2][q] = *(const f32x4*)(cb + c); w0[s2][q] = *(const f32x4*)(cw + c); w1[s2][q] = *(const f32x4*)(cw + 5632 + c); w2[s2][q] = *(const f32x4*)(cw + 2 * 5632 + c); }
        u32x4 p1[2], p2[2];
#pragma unroll
        for (int s2 = 0; s2 < 2; ++s2) { p1[s2] = hh1[s2]; p2[s2] = hh2[s2]; }
#pragma unroll 4
        for (int rr = 0; rr < R; ++rr) {
            const size_t row = row0 + rr; u32x4 u0[2]; float res[2][8];
#pragma unroll
            for (int s2 = 0; s2 < 2; ++s2) u0[s2] = *(const u32x4*)(U + row * 5632 + s2 * DFF + j);
#pragma unroll
            for (int s2 = 0; s2 < 2; ++s2) {
                const float x0[8] = {bf_lo(u0[s2].x), bf_hi(u0[s2].x), bf_lo(u0[s2].y), bf_hi(u0[s2].y), bf_lo(u0[s2].z), bf_hi(u0[s2].z), bf_lo(u0[s2].w), bf_hi(u0[s2].w)};
                const float x1[8] = {bf_lo(p1[s2].x), bf_hi(p1[s2].x), bf_lo(p1[s2].y), bf_hi(p1[s2].y), bf_lo(p1[s2].z), bf_hi(p1[s2].z), bf_lo(p1[s2].w), bf_hi(p1[s2].w)};
                const float x2[8] = {bf_lo(p2[s2].x), bf_hi(p2[s2].x), bf_lo(p2[s2].y), bf_hi(p2[s2].y), bf_lo(p2[s2].z), bf_hi(p2[s2].z), bf_lo(p2[s2].w), bf_hi(p2[s2].w)};
#pragma unroll
                for (int q = 0; q < 2; ++q)
#pragma unroll
                    for (int i = 0; i < 4; ++i) res[s2][4 * q + i] = wb[s2][q][i] + w0[s2][q][i] * x2[4 * q + i] + w1[s2][q][i] * x1[4 * q + i] + w2[s2][q][i] * x0[4 * q + i];
                p2[s2] = p1[s2]; p1[s2] = u0[s2];
            }
            float o[8];
#pragma unroll
            for (int i = 0; i < 8; ++i) { const float gt = res[0][i]; o[i] = gt * sigm(gt) * res[1][i]; }
            u32x4 w; w.x = pk_bf16(o[0], o[1]); w.y = pk_bf16(o[2], o[3]); w.z = pk_bf16(o[4], o[5]); w.w = pk_bf16(o[6], o[7]);
            *(u32x4*)(U + row * 5632 + j) = w;
        }
    };
    auto load_halo = [&](const size_t it, u32x4 (&hh1)[2], u32x4 (&hh2)[2], const bool fu) {
        const size_t seg = it / 352; const int j = (int)(it % 352) * 8; const size_t row0 = seg * R;
#pragma unroll
        for (int s2 = 0; s2 < 2; ++s2) { hh1[s2] = (u32x4){0u, 0u, 0u, 0u}; hh2[s2] = (u32x4){0u, 0u, 0u, 0u};
            if (fu) { if ((row0 & 4095) != 0) { hh1[s2] = *(const u32x4*)(U + (row0 - 1) * 5632 + s2 * DFF + j); hh2[s2] = *(const u32x4*)(U + (row0 - 2) * 5632 + s2 * DFF + j); } }
            else { hh1[s2] = *(const u32x4*)(HALO + (seg * 2 + 0) * 5632 + s2 * DFF + j); hh2[s2] = *(const u32x4*)(HALO + (seg * 2 + 1) * 5632 + s2 * DFF + j); } }
    };
    u32x4 h1[MAXIT][2], h2[MAXIT][2];
#pragma unroll
    for (int k = 0; k < MAXIT; ++k) { const size_t it = gtid + (size_t)k * gsz; if (it < nitems) load_halo(it, h1[k], h2[k], from_u); }
    if (from_u) xcd_barrier(WV, bar, bst);
#pragma unroll
    for (int k = 0; k < MAXIT; ++k) { const size_t it = gtid + (size_t)k * gsz; if (it < nitems) process(it, h1[k], h2[k]); }
    for (size_t it = gtid + (size_t)MAXIT * gsz; it < nitems; it += gsz) { u32x4 a1[2], a2[2]; load_halo(it, a1, a2, false); process(it, a1, a2); }
}

template <int MODE> __device__ __forceinline__ void gemm_call(const int WV, lds_t lds, const pg8::Gemm g, const pg8::EpiArgs ea) {
    pg8::StaticOrder S; S.init(g.M, g.N, (int)gridDim.x, (int)blockIdx.x); pg8::Epi<MODE> E; E.a = ea; pg8::gemm_phase(WV, lds, g, S, E);
}
template <unsigned KM> __global__ void __launch_bounds__(NTHREADS, 2) fwd_kernel(Args Aval) {
    extern __shared__ __attribute__((aligned(16))) unsigned char lds_raw[];
    lds_t lds = (lds_t)lds_raw;
    const kargs_t A0 = (kargs_t)__builtin_amdgcn_kernarg_segment_ptr();
    const int WV = __builtin_amdgcn_readfirstlane(threadIdx.x >> 6);
    const int lo = A0->ph_lo, hi = A0->ph_hi; int ph = 0;
    unsigned* const bar = (unsigned*)(A0->ws + WS_BAR);
    volatile LAS unsigned* const bst = (volatile LAS unsigned*)(lds + 131072);
    if (hi > N_PHASES) cg::this_grid().sync();
    if (hi - lo > 1) {
        if (ltid() == 0) { bst[0] = 0u; bst[1] = 0u; (void)xb_add(&bar[XB_XCNT(xb_xcc_id())], 1u); }
        __syncthreads();
    }
    const int G = gridDim.x, bid = blockIdx.x;
#ifndef REP_MASK
#define REP_MASK 0u
#endif
#ifndef KIND_MASK
#define KIND_MASK 0xFFFFFFFFu
#endif
#define PH_BEGIN(k) if (ph >= lo && ph < hi) { if constexpr (((KM) >> (k)) & 1u) { for (int rep_ = 0; rep_ < ((((REP_MASK) >> (k)) & 1u) ? 2 : 1); ++rep_) { if (rep_) xcd_barrier(WV, bar, bst); const kargs_t A = launder_args(A0); unsigned char* const ws = A->ws; const float* const ada = (const float*)(ws + WS_ADA); (void)ada;
#define PH_END } } if (ph + 1 < hi) { xcd_barrier(WV, bar, bst); } } ++ph;
    using namespace pg8;
#ifdef PROBE_SYNCS
    if (hi - lo > 1) { for (int i_ = 0; i_ < PROBE_SYNCS; ++i_) cg::this_grid().sync(); }
#endif
    PH_BEGIN(0) p0_weights(WV, A, lds); PH_END
    PH_BEGIN(1) norm_rows<true, true>(WV, A->in[I_X], A->in[I_N1W], ada + 0, ada + 1024, ws + WS_H1, MTOK, 0); PH_END
    PH_BEGIN(2) { Gemm g{(const bf16_t*)(ws + WS_H1), (const bf16_t*)(ws + WS_WINRW), MTOK, NRW, 1024, 1024, 1024}; EpiArgs ea{}; ea.o0 = (bf16_t*)(ws + WS_PRW); ea.ld0 = NRW; ea.ncol0 = 1 << 30; gemm_call<EP_BF16>(WV, lds, g, ea); } PH_END
    PH_BEGIN(3) lora_prep(WV, A); PH_END
    PH_BEGIN(4) { Gemm g{(const bf16_t*)(ws + WS_ALORA), (const bf16_t*)(ws + WS_WLORA), MTOK, 2048, 256, 384, 384}; EpiArgs ea{}; ea.o0 = (bf16_t*)(ws + WS_EA); ea.ld0 = 2048; ea.p0 = A->in[I_W0]; ea.p1 = A->in[I_A0]; gemm_call<EP_EA>(WV, lds, g, ea); } PH_END
    PH_BEGIN(5) scan_phase(WV, A, lds); PH_END
    PH_BEGIN(6) { Gemm g{(const bf16_t*)(ws + WS_ALORA) + 128, (const bf16_t*)(ws + WS_WLORA) + (size_t)2048 * 384 + 128, MTOK, 1024, 256, 384, 384}; EpiArgs ea{}; ea.o0 = (bf16_t*)(ws + WS_G); ea.ld0 = 1024; ea.ncol0 = 1 << 30; gemm_call<EP_BF16>(WV, lds, g, ea); } PH_END
    PH_BEGIN(7) post_phase(WV, A); PH_END
    for (int ck = 0; ck < 2; ++ck) {
        const size_t roff = (size_t)ck * CH;
        if (ck == 0) { PH_BEGIN(8) norm_rows<true, true>(WV, A->in[I_X], A->in[I_N1W], ada + 0, ada + 1024, ws + WS_H1C, CH, 0); PH_END }
        PH_BEGIN(9) { Gemm g{(const bf16_t*)(ws + WS_H1C), (const bf16_t*)(ws + WS_WINAG), CH, NAG, 1024, 1024, 1024}; EpiArgs ea{}; ea.o0 = (bf16_t*)(ws + WS_PATT); ea.ld0 = 4608; ea.ncol0 = 4608; ea.o1 = (bf16_t*)(ws + WS_PGATE) + roff * 2048; ea.ld1 = 2048; gemm_call<EP_BF16>(WV, lds, g, ea); } PH_END
        PH_BEGIN(10) attn_phase(WV, A, lds); PH_END
        PH_BEGIN(11) combine_phase(WV, A, roff);
                     if (ck == 0) norm_rows<true, true>(WV, A->in[I_X] + (size_t)CH * 1024, A->in[I_N1W], ada + 0, ada + 1024, ws + WS_H1C, CH, CH); PH_END
    }
    PH_BEGIN(12) { { Gemm g{(const bf16_t*)(ws + WS_ATTM), (const bf16_t*)(ws + WS_WATTO), MTOK, 1024, 512, 512, 512}; EpiArgs ea{}; ea.gate = (const bf16_t*)(ws + WS_PGATE); ea.p0 = A->in[I_BGATE]; ea.t1 = (float*)(ws + WS_T1); gemm_call<EP_ATTOUT>(WV, lds, g, ea); }
                   { Gemm g{(const bf16_t*)(ws + WS_RWO), (const bf16_t*)(ws + WS_WRWO), MTOK, 1024, 1024, 1024, 1024}; EpiArgs ea{}; ea.gate = (const bf16_t*)(ws + WS_PGATE); ea.p0 = A->in[I_BGATE]; ea.t1 = (float*)(ws + WS_T1); ea.o0 = (bf16_t*)(ws + WS_MIX); gemm_call<EP_RWOUT>(WV, lds, g, ea); } } PH_END
    PH_BEGIN(14) { Gemm g{(const bf16_t*)(ws + WS_MIX), (const bf16_t*)(ws + WS_WO), MTOK, 1024, 1024, 1024, 1024}; EpiArgs ea{}; ea.p0 = ada + 2048; ea.row0g = 0; ea.base = A->in[I_X]; ea.outf = A->out; gemm_call<EP_RESID>(WV, lds, g, ea); } PH_END
    PH_BEGIN(15) p_ffn_weights(WV, A, lds);
                 norm_rows<true, true>(WV, A->out, A->in[I_N2W], ada + 3072, ada + 4096, ws + WS_H2, MTOK, 0); PH_END
    PH_BEGIN(16) { Gemm g{(const bf16_t*)(ws + WS_H2), (const bf16_t*)(ws + WS_WUP), MTOK, 5632, 1024, 1024, 1024}; EpiArgs ea{}; ea.o0 = (bf16_t*)(ws + WS_U); ea.ld0 = 5632; ea.ncol0 = 1 << 30; gemm_call<EP_BF16>(WV, lds, g, ea); } PH_END
#if !MK_ONE_LAUNCH
    PH_BEGIN(13) halo_phase(WV, A); PH_END
#endif
    PH_BEGIN(17) conv_phase(WV, A, bar, bst, MK_ONE_LAUNCH != 0); PH_END
    PH_BEGIN(18) { Gemm g{(const bf16_t*)(ws + WS_U), (const bf16_t*)(ws + WS_WDN), MTOK, 1024, DFF, 5632, DFF}; EpiArgs ea{}; ea.p0 = ada + 5120; ea.row0g = 0; ea.base = A->out; ea.outf = A->out; gemm_call<EP_RESID>(WV, lds, g, ea); } PH_END
    PH_BEGIN(19) norm_rows<false, false>(WV, A->out, A->in[I_NFW], nullptr, nullptr, A->out, MTOK, 0); PH_END
#undef PH_BEGIN
#undef PH_END
}

constexpr unsigned LIGHT_MASK = (1u << 0) | (1u << 1) | (1u << 3) | (1u << 7) | (1u << 8) | (1u << 11) | (1u << 13) | (1u << 15) | (1u << 17) | (1u << 19);
#if MK_ONE_LAUNCH
static const int kind_of_phase[N_PHASES] = {0, 1, 2, 3, 4, 5, 6, 7, 8, 9, 10, 11, 9, 10, 11, 12, 14, 15, 16, 17, 18, 19};
#else
static const int kind_of_phase[N_PHASES] = {0, 1, 2, 3, 4, 5, 6, 7, 8, 9, 10, 11, 9, 10, 11, 12, 14, 15, 16, 13, 17, 18, 19};
#endif
typedef void (*kfn_t)(Args);
static kfn_t kernel_for_kind(int k) {
#if MK_ONE_LAUNCH
    (void)k; return fwd_kernel<0xFFFFFu>;
#else
    switch (k) {
        case 2: return fwd_kernel<1u << 2>; case 4: return fwd_kernel<1u << 4>; case 5: return fwd_kernel<1u << 5>; case 6: return fwd_kernel<1u << 6>;
        case 9: return fwd_kernel<1u << 9>; case 10: return fwd_kernel<1u << 10>; case 12: return fwd_kernel<1u << 12>; case 13: return fwd_kernel<1u << 13>;
        case 14: return fwd_kernel<1u << 14>; case 16: return fwd_kernel<1u << 16>; case 18: return fwd_kernel<1u << 18>;
        default: return fwd_kernel<LIGHT_MASK>;
    }
#endif
}
extern "C" void kernel_launch(void* const* d_in, const int* in_sizes, int n_in, void* d_out, int out_size, void* d_ws, size_t ws_size, hipStream_t stream) {
    static int grid = 0;
    if (grid == 0) {
        if (n_in != 27 || out_size != MTOK * D || ws_size < WS_NEED) { fprintf(stderr, "kernel_launch: unexpected shapes (n_in %d out %d ws %zu, need %zu)\n", n_in, out_size, ws_size, (size_t)WS_NEED); grid = -1; return; }
        int dev = 0, cus = 0;
        if (hipGetDevice(&dev) != hipSuccess || hipDeviceGetAttribute(&cus, hipDeviceAttributeMultiprocessorCount, dev) != hipSuccess) cus = 256;
        for (int k = 0; k < 20; ++k)
            if (hipFuncSetAttribute((const void*)kernel_for_kind(k), hipFuncAttributeMaxDynamicSharedMemorySize, LDS_BYTES) != hipSuccess) { fprintf(stderr, "kernel_launch: hipFuncSetAttribute failed\n"); grid = -1; return; }
        (void)hipGetLastError();
        grid = cus > 0 ? cus : 256;
    }
    if (grid < 0) return;
    Args a{};
    for (int i = 0; i < 27; ++i) a.in[i] = (const float*)d_in[i];
    a.out = (float*)d_out; a.ws = (unsigned char*)d_ws;
#if MK_ONE_LAUNCH
    a.ph_lo = 0; a.ph_hi = N_PHASES;
    if (hipMemsetAsync((char*)d_ws + WS_BAR, 0, XCD_BAR_WORDS * sizeof(unsigned), stream) != hipSuccess) { fprintf(stderr, "kernel_launch: memset of barrier words failed\n"); return; }
    void* args[] = {&a};
    hipError_t e = hipLaunchCooperativeKernel((const void*)fwd_kernel<0xFFFFFu>, dim3(grid), dim3(NTHREADS), args, LDS_BYTES, stream);
    if (e != hipSuccess) fprintf(stderr, "kernel_launch: cooperative launch failed: %s (grid %d)\n", hipGetErrorString(e), grid);
#else
    for (int p = 0; p < N_PHASES; ++p) {
        a.ph_lo = p; a.ph_hi = p + 1;
        hipLaunchKernelGGL(kernel_for_kind(kind_of_phase[p]), dim3(grid), dim3(NTHREADS), LDS_BYTES, stream, a);
    }
#endif
}
```

```cpp
#include <hip/hip_runtime.h>
#include <hip/hip_cooperative_groups.h>
#include <cstdio>
#include <cstdint>
namespace cg = cooperative_groups;

#ifndef MK_ONE_LAUNCH
#define MK_ONE_LAUNCH 1
#endif

#define LAS __attribute__((address_space(3)))
typedef unsigned short bf16_t;
typedef short bf16x8 __attribute__((ext_vector_type(8)));
typedef float f32x4 __attribute__((ext_vector_type(4)));
typedef float f32x2 __attribute__((ext_vector_type(2)));
typedef unsigned u32x4 __attribute__((ext_vector_type(4)));
typedef unsigned u32x2 __attribute__((ext_vector_type(2)));
typedef LAS unsigned char* lds_t;

constexpr int SEQ = 4096, NB = 8, D = 1024, MTOK = NB * SEQ;
constexpr int NRW = 3584;
constexpr int NAG = 6656;
constexpr int DFF = 2816;
constexpr int CH = 16384;
constexpr int NTHREADS = 512;
constexpr int LDS_BYTES = 131072 + 16;
constexpr int N_PHASES = 8 + (4 + 3) + 2 + (MK_ONE_LAUNCH ? 5 : 6);

constexpr size_t MiB = 1048576;
constexpr size_t WS_WATTO = 0 * MiB, WS_WRWO = 1 * MiB, WS_WO = 3 * MiB, WS_WLORA = 5 * MiB, WS_ADA = 7 * MiB + 512 * 1024;
constexpr size_t WS_WINRW = 8 * MiB, WS_WINAG = 15 * MiB;
constexpr size_t WS_H1 = 45 * MiB, WS_Y = 45 * MiB, WS_PRW = 109 * MiB, WS_ALORA = 333 * MiB, WS_EA = 357 * MiB, WS_BS = 485 * MiB;
constexpr size_t WS_G = 357 * MiB, WS_RWO = 421 * MiB;
constexpr size_t WS_H1C = 28 * MiB, WS_PATT = 60 * MiB, WS_ATTO = 204 * MiB, WS_LSE = 8 * MiB, WS_PGATE = 252 * MiB, WS_ATTM = 380 * MiB;
constexpr size_t WS_T1 = 28 * MiB, WS_MIX = 156 * MiB;
constexpr size_t WS_WUP = 8 * MiB, WS_WDN = 19 * MiB, WS_H2 = 28 * MiB, WS_U = 92 * MiB, WS_HALO = 444 * MiB;
constexpr size_t WS_BAR = 503 * MiB;
constexpr size_t WS_NEED = 504 * MiB;

__device__ __forceinline__ float bf_lo(unsigned u) { return __uint_as_float(u << 16); }
__device__ __forceinline__ float bf_hi(unsigned u) { return __uint_as_float(u & 0xffff0000u); }
__device__ __forceinline__ float bf2f(bf16_t v) { return __uint_as_float(((unsigned)v) << 16); }
__device__ __forceinline__ unsigned pk_bf16(float lo, float hi) { unsigned r; asm volatile("v_cvt_pk_bf16_f32 %0, %1, %2" : "=v"(r) : "v"(lo), "v"(hi)); return r; }
__device__ __forceinline__ bf16_t f2bf(float f) { return (bf16_t)(pk_bf16(f, 0.f) & 0xffffu); }
__device__ __forceinline__ int lane_id_asm() { int l; asm volatile("v_mbcnt_lo_u32_b32 %0, -1, 0\n\tv_mbcnt_hi_u32_b32 %0, -1, %0" : "=v"(l)); return l; }
__device__ __forceinline__ int ltid_w(int w) { asm volatile("" : "+s"(w)); return w * 64 + lane_id_asm(); }
#define ltid() ltid_w(WV)
__device__ __forceinline__ float sigm(float x) { return __builtin_amdgcn_rcpf(1.0f + __expf(-x)); }
template <int CTRL> __device__ __forceinline__ float dppf(float x) { return __builtin_bit_cast(float, __builtin_amdgcn_mov_dpp(__builtin_bit_cast(int, x), CTRL, 0xf, 0xf, true)); }
__device__ __forceinline__ float allred16(float x) { x += dppf<0xB1>(x); x += dppf<0x4E>(x); x += dppf<0x141>(x); x += dppf<0x128>(x); return x; }

namespace pg8 {
constexpr int BM = 256, BK = 64, HALF = 128, HTB = HALF * BK * 2, STAGE_BYTES = 8 * HTB, NXCD = 8, WGM = 2;
__host__ __device__ __forceinline__ int lds_byte(int r, int c) { const int st = (r >> 4) * 2 + (c >> 5), rr = r & 15, cc = c & 31, ob = rr * 64 + cc * 2; return st * 1024 + (ob ^ (((ob >> 9) & 1) << 5)); }
__host__ __device__ __forceinline__ void stage_rc(int b, int& R, int& C) { const int st = b / 1024, sb = b % 1024, swz = sb ^ (((sb >> 9) & 1) << 5); R = (st >> 1) * 16 + swz / 64; C = (st & 1) * 32 + (swz % 64) / 2; }
__host__ __device__ __forceinline__ int perm32(int rho) { const int n = rho >> 4, i = rho & 15; return 8 * (i >> 2) + 4 * n + (i & 3); }
struct Unit { int pm, pn; };
struct Gemm { const bf16_t* A; const bf16_t* Bt; int M, N, K, lda, ldb; };
struct StaticOrder {
    int nM, nN, nwg, G, c;
    __device__ void init(int M, int N, int G_, int c_) { nM = M / BM; nN = N / BM; nwg = nM * nN; G = G_; c = c_; }
    __device__ bool next(int i, Unit& u) const {
        const long L = (long)i * G + c; if (L >= nwg) return false;
        int wgid = (int)L; { const int q = nwg / NXCD, r = nwg % NXCD, xcd = wgid % NXCD, off = wgid / NXCD; wgid = (xcd < r ? xcd * (q + 1) : r * (q + 1) + (xcd - r) * q) + off; }
        const int nig = WGM * nN, gid = wgid / nig, fm = gid * WGM, gsz = (nM - fm) < WGM ? (nM - fm) : WGM;
        u.pm = fm + ((wgid % nig) % gsz); u.pn = (wgid % nig) / gsz; return true;
    }
};

template <class Epi, bool ALIGN_EPI = true>
__device__ __forceinline__ void gemm_phase(const int WV, lds_t lds, const Gemm g, const StaticOrder& S, const Epi& E) {
    const int tid = ltid(), wid = __builtin_amdgcn_readfirstlane(tid >> 6), lane = tid & 63, wr = wid >> 2, wc = wid & 3, fr = lane & 15, fq = lane >> 4;
    const int K = g.K, nt = K / BK;
    unsigned voffA[2], voffB[2];
#pragma unroll
    for (int i = 0; i < 2; ++i) { int R, C; stage_rc(tid * 16 + i * 8192, R, C); const int Rb = Epi::PERM ? ((R & ~31) + perm32(R & 31)) : R;
        voffA[i] = (unsigned)(R * g.lda + C) * 2u; voffB[i] = (unsigned)(Rb * g.ldb + C) * 2u; }
    const size_t kstep = (size_t)(BK * 2);
    const size_t hstepA = (size_t)HALF * g.lda * 2, hstepB = (size_t)HALF * g.ldb * 2;
    const size_t tstepA = 2 * hstepA, tstepB = 2 * hstepB;
    const unsigned ldsw = (unsigned)wid * 1024u;
    const int aoff = lds_byte(wr * 64 + fr, fq * 8), boff = lds_byte(wc * 32 + fr, fq * 8);
#define PG8_SA(b, h) (((b) * 2 + (h)) * HTB)
#define PG8_SB(b, h) ((4 + (b) * 2 + (h)) * HTB)
#define PG8_STAGE(bufoff, gbase, voff) do { _Pragma("unroll") for (int _i = 0; _i < 2; ++_i) \
        __builtin_amdgcn_global_load_lds((const unsigned*)((const char*)(gbase) + (voff)[_i]), (LAS unsigned*)(lds + (bufoff) + ldsw + _i * 8192), 16, 0, 0); } while (0)
#define PG8_LDA(dst, b, h) do { _Pragma("unroll") for (int m = 0; m < 4; ++m) _Pragma("unroll") for (int k = 0; k < 2; ++k) dst[m][k] = *(const LAS bf16x8*)(lds + PG8_SA(b, h) + aoff + m * 2048 + k * 1024); } while (0)
#define PG8_LDB(dst, b, h) do { _Pragma("unroll") for (int n = 0; n < 2; ++n) _Pragma("unroll") for (int k = 0; k < 2; ++k) dst[n][k] = *(const LAS bf16x8*)(lds + PG8_SB(b, h) + boff + n * 2048 + k * 1024); } while (0)
#define PG8_MMA(ai, bj, At, Bt) do { __builtin_amdgcn_s_setprio(1); _Pragma("unroll") for (int m = 0; m < 4; ++m) _Pragma("unroll") for (int n = 0; n < 2; ++n) _Pragma("unroll") for (int k = 0; k < 2; ++k) \
        acc[ai][bj][m][n] = __builtin_amdgcn_mfma_f32_16x16x32_bf16(Bt[n][k], At[m][k], acc[ai][bj][m][n], 0, 0, 0); __builtin_amdgcn_s_setprio(0); } while (0)
#define PG8_WAIT_V(n) asm volatile("s_waitcnt vmcnt(" #n ")" ::: "memory")
#define PG8_WAIT_L(n) asm volatile("s_waitcnt lgkmcnt(" #n ")" ::: "memory")
#define PG8_BAR __builtin_amdgcn_s_barrier()
#define PG8_SCHED __builtin_amdgcn_sched_barrier(0)
    Unit cur, nxt; int ui = 0;
    if (!S.next(0, cur)) return;
    f32x4 acc[2][2][4][2];
#pragma unroll
    for (int a = 0; a < 2; ++a)
#pragma unroll
        for (int b = 0; b < 2; ++b)
#pragma unroll
            for (int m = 0; m < 4; ++m)
#pragma unroll
                for (int n = 0; n < 2; ++n) acc[a][b][m][n] = (f32x4){0.f, 0.f, 0.f, 0.f};
    bf16x8 At[4][2], B0[2][2], B1[2][2];
    const char* cA = (const char*)g.A + (size_t)cur.pm * tstepA; const char* cB = (const char*)g.Bt + (size_t)cur.pn * tstepB;
    PG8_STAGE(PG8_SB(0, 0), cB, voffB); PG8_STAGE(PG8_SB(0, 1), cB + hstepB, voffB); PG8_STAGE(PG8_SA(0, 0), cA, voffA); PG8_STAGE(PG8_SA(0, 1), cA + hstepA, voffA);
    if (wr == 1) PG8_BAR;
    PG8_WAIT_V(2); PG8_BAR;
    PG8_STAGE(PG8_SB(1, 0), cB + kstep, voffB); PG8_STAGE(PG8_SA(1, 0), cA + kstep, voffA); PG8_STAGE(PG8_SB(1, 1), cB + hstepB + kstep, voffB);
    PG8_WAIT_V(6); PG8_BAR;
    for (;;) {
        const bool has_next = S.next(ui + 1, nxt);
        const char* nA = has_next ? (const char*)g.A + (size_t)nxt.pm * tstepA : cA; const char* nB = has_next ? (const char*)g.Bt + (size_t)nxt.pn * tstepB : cB;
        for (int t = 0; t < nt; t += 2) {
            const bool last = (t == nt - 2);
            const char* a1 = cA + (size_t)(t + 1) * kstep;
            const char* a2 = last ? nA : cA + (size_t)(t + 2) * kstep; const char* b2 = last ? nB : cB + (size_t)(t + 2) * kstep;
            const char* a3 = a2 + kstep; const char* b3 = b2 + kstep;
            PG8_LDB(B0, 0, 0); PG8_LDB(B1, 0, 1); PG8_SCHED; PG8_LDA(At, 0, 0); PG8_STAGE(PG8_SA(1, 1), a1 + hstepA, voffA);
            PG8_WAIT_V(8); PG8_WAIT_L(0); PG8_BAR; PG8_MMA(0, 0, At, B0); PG8_MMA(0, 1, At, B1); PG8_BAR; PG8_SCHED;
            PG8_LDA(At, 0, 1); PG8_STAGE(PG8_SB(0, 0), b2, voffB); PG8_STAGE(PG8_SB(0, 1), b2 + hstepB, voffB); PG8_STAGE(PG8_SA(0, 0), a2, voffA);
            PG8_WAIT_V(8); PG8_WAIT_L(0); PG8_BAR; PG8_MMA(1, 0, At, B0); PG8_MMA(1, 1, At, B1); PG8_BAR; PG8_SCHED;
            PG8_LDB(B0, 1, 0); PG8_LDB(B1, 1, 1); PG8_SCHED; PG8_LDA(At, 1, 0); PG8_STAGE(PG8_SA(0, 1), a2 + hstepA, voffA);
            PG8_WAIT_V(8); PG8_WAIT_L(0); PG8_BAR; PG8_MMA(0, 0, At, B0); PG8_MMA(0, 1, At, B1); PG8_BAR; PG8_SCHED;
            PG8_LDA(At, 1, 1); PG8_STAGE(PG8_SB(1, 0), b3, voffB); PG8_STAGE(PG8_SB(1, 1), b3 + hstepB, voffB); PG8_STAGE(PG8_SA(1, 0), a3, voffA);
            PG8_WAIT_V(8); PG8_WAIT_L(0); PG8_BAR; PG8_MMA(1, 0, At, B0); PG8_MMA(1, 1, At, B1); PG8_BAR; PG8_SCHED;
        }
        if constexpr (ALIGN_EPI) { if (wr == 0) PG8_BAR; }
        E(acc, cur, wr, wc, fr, fq);
        if (!has_next) break;
#pragma unroll
        for (int a = 0; a < 2; ++a)
#pragma unroll
            for (int b = 0; b < 2; ++b)
#pragma unroll
                for (int m = 0; m < 4; ++m)
#pragma unroll
                    for (int n = 0; n < 2; ++n) acc[a][b][m][n] = (f32x4){0.f, 0.f, 0.f, 0.f};
        cur = nxt; cA = nA; cB = nB; ++ui;
        if constexpr (ALIGN_EPI) { if (wr == 1) PG8_BAR; }
    }
    PG8_WAIT_V(0);
    if constexpr (!ALIGN_EPI) { if (wr == 0) PG8_BAR; }
    PG8_BAR;
#undef PG8_SA
#undef PG8_SB
#undef PG8_STAGE
#undef PG8_LDA
#undef PG8_LDB
#undef PG8_MMA
#undef PG8_WAIT_V
#undef PG8_WAIT_L
#undef PG8_BAR
#undef PG8_SCHED
}

enum { EP_BF16 = 0, EP_EA = 1, EP_ATTOUT = 2, EP_RWOUT = 3, EP_RESID = 4, EP_EAH = 5 };
struct EpiArgs {
    bf16_t* o0; bf16_t* o1; int ld0, ld1, ncol0, row0g;
    const float* p0; const float* p1;
    const bf16_t* gate; float* t1; const float* base; float* outf;
};
template <int MODE> struct Epi {
    static constexpr bool PERM = (MODE == EP_BF16 || MODE == EP_EA || MODE == EP_RWOUT || MODE == EP_EAH);
    EpiArgs a;
    __device__ __forceinline__ void operator()(const f32x4 (&acc)[2][2][4][2], const Unit& u, int wr, int wc, int fr, int fq) const {
        { const int l_ = lane_id_asm(); fr = l_ & 15; fq = l_ >> 4; }
        const int row0 = u.pm * BM + wr * 64 + fr;
        if constexpr (MODE == EP_BF16) {
            int colt = u.pn * BM; bf16_t* base = a.o0; int ld = a.ld0;
            if (colt >= a.ncol0) { base = a.o1; ld = a.ld1; colt -= a.ncol0; }
            const int col0 = colt + wc * 32 + 8 * fq;
#pragma unroll
            for (int ai = 0; ai < 2; ++ai)
#pragma unroll
                for (int m = 0; m < 4; ++m) { bf16_t* rowp = base + (size_t)(row0 + ai * HALF + m * 16) * ld + col0;
#pragma unroll
                    for (int bj = 0; bj < 2; ++bj) { const f32x4 v0 = acc[ai][bj][m][0], v1 = acc[ai][bj][m][1];
                        u32x4 w; w.x = pk_bf16(v0[0], v0[1]); w.y = pk_bf16(v0[2], v0[3]); w.z = pk_bf16(v1[0], v1[1]); w.w = pk_bf16(v1[2], v1[3]);
                        *(u32x4*)(rowp + bj * HALF) = w; }
                    asm volatile("" ::: "memory"); }
        } else if constexpr (MODE == EP_EAH) {
            const int frl = fr, fql = fq;
            const int rb = u.pm * BM, bb = rb >> 12, t0 = (rb & 4095) + wr * 64 + frl;
            const int c0 = u.pn * BM + wc * 32 + 8 * fql, c1 = c0 + HALF;
            const unsigned of0 = (unsigned)(bb * 16 + ((c0 >> 6) & 15)) * 524288u + (unsigned)t0 * 128u + (unsigned)((c0 >> 10) * 64 + (c0 & 63));
            const unsigned of1 = (unsigned)(bb * 16 + ((c1 >> 6) & 15)) * 524288u + (unsigned)t0 * 128u + (unsigned)((c1 >> 10) * 64 + (c1 & 63));
#pragma unroll
            for (int ai = 0; ai < 2; ++ai)
#pragma unroll
                for (int m = 0; m < 4; ++m) {
#pragma unroll
                    for (int bj = 0; bj < 2; ++bj) { const f32x4 v0 = acc[ai][bj][m][0], v1 = acc[ai][bj][m][1];
                        u32x4 w; w.x = pk_bf16(v0[0], v0[1]); w.y = pk_bf16(v0[2], v0[3]); w.z = pk_bf16(v1[0], v1[1]); w.w = pk_bf16(v1[2], v1[3]);
                        *(u32x4*)(a.o0 + ((bj ? of1 : of0) + (unsigned)((ai * HALF + m * 16) * 128))) = w; }
                    asm volatile("" ::: "memory"); }
        } else if constexpr (MODE == EP_EA) {
            const int col0 = u.pn * BM + wc * 32 + 8 * fq;
            const bool isw = (u.pn < 4);
            const float* bias = isw ? a.p0 : (a.p1 - 1024);
            const float scl = isw ? 0.60653066f : 1.0f;
#pragma unroll
            for (int ai = 0; ai < 2; ++ai)
#pragma unroll
                for (int m = 0; m < 4; ++m) { bf16_t* rowp = a.o0 + (size_t)(row0 + ai * HALF + m * 16) * a.ld0 + col0;
#pragma unroll
                    for (int bj = 0; bj < 2; ++bj) { const f32x4 bv0 = *(const f32x4*)(bias + col0 + bj * HALF), bv1 = *(const f32x4*)(bias + col0 + bj * HALF + 4);
                        f32x4 v0 = acc[ai][bj][m][0] + bv0, v1 = acc[ai][bj][m][1] + bv1;
#pragma unroll
                        for (int j = 0; j < 4; ++j) { v0[j] = scl * sigm(v0[j]); v1[j] = scl * sigm(v1[j]); }
                        u32x4 w; w.x = pk_bf16(v0[0], v0[1]); w.y = pk_bf16(v0[2], v0[3]); w.z = pk_bf16(v1[0], v1[1]); w.w = pk_bf16(v1[2], v1[3]);
                        *(u32x4*)(rowp + bj * HALF) = w; }
                    asm volatile("" ::: "memory"); }
        } else if constexpr (MODE == EP_ATTOUT) {
            const int col0 = u.pn * BM + wc * 32 + 4 * fq;
#pragma unroll
            for (int ai = 0; ai < 2; ++ai)
#pragma unroll
                for (int m = 0; m < 4; ++m) { const size_t r = (size_t)(row0 + ai * HALF + m * 16);
#pragma unroll
                    for (int bj = 0; bj < 2; ++bj)
#pragma unroll
                        for (int n = 0; n < 2; ++n) { const int c = col0 + bj * HALF + n * 16;
                            const u32x2 gq = *(const u32x2*)(a.gate + r * 2048 + c); const f32x4 bg = *(const f32x4*)(a.p0 + c);
                            const f32x4 v = acc[ai][bj][m][n]; f32x4 o;
                            o[0] = sigm(bf_lo(gq.x) + bg[0]) * v[0]; o[1] = sigm(bf_hi(gq.x) + bg[1]) * v[1]; o[2] = sigm(bf_lo(gq.y) + bg[2]) * v[2]; o[3] = sigm(bf_hi(gq.y) + bg[3]) * v[3];
                            *(f32x4*)(a.t1 + r * 1024 + c) = o; }
                    asm volatile("" ::: "memory"); }
        } else if constexpr (MODE == EP_RWOUT) {
            const int col0 = u.pn * BM + wc * 32 + 8 * fq;
#pragma unroll
            for (int ai = 0; ai < 2; ++ai)
#pragma unroll
                for (int m = 0; m < 4; ++m) { const size_t r = (size_t)(row0 + ai * HALF + m * 16);
#pragma unroll
                    for (int bj = 0; bj < 2; ++bj) { const int c = col0 + bj * HALF;
                        const u32x4 gq = *(const u32x4*)(a.gate + r * 2048 + 1024 + c);
                        const f32x4 b0 = *(const f32x4*)(a.p0 + 1024 + c), b1 = *(const f32x4*)(a.p0 + 1024 + c + 4);
                        const f32x4 t0 = *(const f32x4*)(a.t1 + r * 1024 + c), t1v = *(const f32x4*)(a.t1 + r * 1024 + c + 4);
                        const f32x4 v0 = acc[ai][bj][m][0], v1 = acc[ai][bj][m][1]; f32x4 o0, o1;
                        o0[0] = t0[0] + sigm(bf_lo(gq.x) + b0[0]) * v0[0]; o0[1] = t0[1] + sigm(bf_hi(gq.x) + b0[1]) * v0[1];
                        o0[2] = t0[2] + sigm(bf_lo(gq.y) + b0[2]) * v0[2]; o0[3] = t0[3] + sigm(bf_hi(gq.y) + b0[3]) * v0[3];
                        o1[0] = t1v[0] + sigm(bf_lo(gq.z) + b1[0]) * v1[0]; o1[1] = t1v[1] + sigm(bf_hi(gq.z) + b1[1]) * v1[1];
                        o1[2] = t1v[2] + sigm(bf_lo(gq.w) + b1[2]) * v1[2]; o1[3] = t1v[3] + sigm(bf_hi(gq.w) + b1[3]) * v1[3];
                        u32x4 w; w.x = pk_bf16(o0[0], o0[1]); w.y = pk_bf16(o0[2], o0[3]); w.z = pk_bf16(o1[0], o1[1]); w.w = pk_bf16(o1[2], o1[3]);
                        *(u32x4*)(a.o0 + r * 1024 + c) = w; }
                    asm volatile("" ::: "memory"); }
        } else {
            const int col0 = u.pn * BM + wc * 32 + 4 * fq;
            const int bidx = (a.row0g + u.pm * BM) >> 12;
            const float* gp = a.p0 + (size_t)bidx * 6144 + col0;
#pragma unroll
            for (int ai = 0; ai < 2; ++ai)
#pragma unroll
                for (int m = 0; m < 4; ++m) { const size_t off = (size_t)(row0 + ai * HALF + m * 16) * 1024 + col0;
#pragma unroll
                    for (int bj = 0; bj < 2; ++bj)
#pragma unroll
                        for (int n = 0; n < 2; ++n) { const f32x4 bs = *(const f32x4*)(a.base + off + bj * HALF + n * 16); const f32x4 gv = *(const f32x4*)(gp + bj * HALF + n * 16);
                            *(f32x4*)(a.outf + off + bj * HALF + n * 16) = bs + gv * acc[ai][bj][m][n]; }
                    asm volatile("" ::: "memory"); }
        }
    }
};
}

#define XB_TMO      128
#define XB_XCNT(j)  (256  + 64 * (j))
#define XB_XSUB(j)  (1280 + 64 * (j))
#define XB_XGEN(j)  (2304 + 64 * (j))
#define XB_TOP      3328
#define XB_TOPGEN   3392
#define XCD_BAR_WORDS 3456
#define XB_SPIN_CAP (1u << 20)
__device__ __forceinline__ unsigned xb_ld(unsigned* p)              { return __hip_atomic_load(p, __ATOMIC_RELAXED, __HIP_MEMORY_SCOPE_AGENT); }
__device__ __forceinline__ unsigned xb_add(unsigned* p, unsigned v) { return __hip_atomic_fetch_add(p, v, __ATOMIC_RELAXED, __HIP_MEMORY_SCOPE_AGENT); }
__device__ __forceinline__ unsigned xb_xcc_id() { return (unsigned)__builtin_amdgcn_s_getreg((3 << 11) | 20) & 0xFu; }
#define XB_SPIN(cond, bar) do { unsigned _sp = 0; while (cond) { __builtin_amdgcn_s_sleep(1); \
    if ((++_sp & 255u) == 0u) { if (xb_ld(&(bar)[XB_TMO])) break; if (_sp > XB_SPIN_CAP) { atomicAdd(&(bar)[XB_TMO], 1u); break; } } } } while (0)
__device__ __forceinline__ void xcd_barrier_complete(unsigned* bar, unsigned x, unsigned& nloc, unsigned& nx) {
    const unsigned G = gridDim.x; unsigned sum, cnt, mine, sp = 0u;
    for (;;) {
        sum = 0u; cnt = 0u; mine = 0u;
#pragma unroll
        for (unsigned j = 0; j < 16; ++j) { const unsigned c = xb_ld(&bar[XB_XCNT(j)]); sum += c; cnt += (c > 0u) ? 1u : 0u; mine = (j == x) ? c : mine; }
        if (sum == G) break;
        __builtin_amdgcn_s_sleep(1);
        if ((++sp & 255u) == 0u) { if (xb_ld(&bar[XB_TMO])) break; if (sp > XB_SPIN_CAP) { atomicAdd(&bar[XB_TMO], 1u); break; } }
    }
    nloc = mine > 0u ? mine : 1u; nx = cnt > 0u ? cnt : 1u;
}
__device__ __forceinline__ void xcd_barrier(const int WV, unsigned* bar, volatile LAS unsigned* st) {
    asm volatile("s_waitcnt vmcnt(0)" ::: "memory");
    __syncthreads();
    if (ltid() == 0) {
        const unsigned x = xb_xcc_id();
        __builtin_amdgcn_s_waitcnt(0);
        unsigned nloc = st[0], nx = st[1];
        if (nloc == 0u) { xcd_barrier_complete(bar, x, nloc, nx); st[0] = nloc; st[1] = nx; }
        const unsigned old = xb_add(&bar[XB_XSUB(x)], 1u);
        const unsigned gen = old / nloc;
        if (old + 1u == (gen + 1u) * nloc) {
            __builtin_amdgcn_fence(__ATOMIC_RELEASE, "agent");
            asm volatile("s_waitcnt vmcnt(0)" ::: "memory");
            const unsigned og = xb_add(&bar[XB_TOP], 1u);
            const unsigned tg = og / nx;
            if (og + 1u == (tg + 1u) * nx) xb_add(&bar[XB_TOPGEN], 1u);
            else XB_SPIN(xb_ld(&bar[XB_TOPGEN]) == tg, bar);
            __builtin_amdgcn_fence(__ATOMIC_ACQUIRE, "agent");
            xb_add(&bar[XB_XGEN(x)], 1u);
            asm volatile("s_waitcnt vmcnt(0)" ::: "memory");
        } else {
            XB_SPIN(xb_ld(&bar[XB_XGEN(x)]) == gen, bar);
            __builtin_amdgcn_fence(__ATOMIC_ACQUIRE, "agent");
            asm volatile("s_waitcnt vmcnt(0)" ::: "memory");
        }
    }
    __syncthreads();
}

struct Args { const float* in[27]; float* out; unsigned char* ws; int ph_lo, ph_hi; };
typedef const __attribute__((address_space(4))) Args* kargs_t;
__device__ __forceinline__ kargs_t launder_args(kargs_t p) { asm volatile("" : "+s"(p)); return p; }
enum { I_X = 0, I_C, I_WADA, I_BADA, I_N1W, I_WIN, I_BGATE, I_MU, I_W0, I_W2, I_A0, I_A2, I_G2, I_KK, I_KA, I_RK, I_LNW, I_LNB, I_WATTO, I_WRWO, I_WO, I_N2W, I_WUP, I_CONVW, I_CONVB, I_WDN, I_NFW };

__device__ __forceinline__ void conv_job(const int WV, const float* src, int ldn, int c0, int K, bf16_t* dst, int ldk, int r0, int nrows, lds_t lds) {
    LAS float* tile = (LAS float*)lds;
    const int tid = ltid(), nkt = K / 64, ntiles = (nrows / 32) * nkt;
    const int kl = tid >> 3, n4 = (tid & 7) * 4, nl = tid >> 4, k4 = (tid & 15) * 4;
    int t = blockIdx.x; f32x4 vn = (f32x4){0.f, 0.f, 0.f, 0.f};
    if (t < ntiles) vn = *(const f32x4*)(src + (size_t)((t % nkt) * 64 + kl) * ldn + c0 + (t / nkt) * 32 + n4);
    for (; t < ntiles; t += gridDim.x) {
        const int n0 = (t / nkt) * 32, k0 = (t % nkt) * 64; const f32x4 v = vn;
        const int tn = t + gridDim.x;
        if (tn < ntiles) vn = *(const f32x4*)(src + (size_t)((tn % nkt) * 64 + kl) * ldn + c0 + (tn / nkt) * 32 + n4);
        tile[kl * 33 + n4 + 0] = v[0]; tile[kl * 33 + n4 + 1] = v[1]; tile[kl * 33 + n4 + 2] = v[2]; tile[kl * 33 + n4 + 3] = v[3];
        __syncthreads();
        { u32x2 w; w.x = pk_bf16(tile[(k4 + 0) * 33 + nl], tile[(k4 + 1) * 33 + nl]); w.y = pk_bf16(tile[(k4 + 2) * 33 + nl], tile[(k4 + 3) * 33 + nl]);
          *(u32x2*)(dst + (size_t)(r0 + n0 + nl) * ldk + k0 + k4) = w; }
        __syncthreads();
    }
}
__device__ __forceinline__ void p0_weights(const int WV, kargs_t A, lds_t lds) {
    unsigned char* ws = A->ws; const int tid = ltid(), G = gridDim.x; const size_t gtid = (size_t)blockIdx.x * NTHREADS + tid, gsz = (size_t)G * NTHREADS;
    conv_job(WV, A->in[I_WIN], 10016, 4608, 1024, (bf16_t*)(ws + WS_WINRW), 1024, 0, 3360, lds);
    conv_job(WV, A->in[I_WIN], 10016, 0, 1024, (bf16_t*)(ws + WS_WINAG), 1024, 0, 4608, lds);
    conv_job(WV, A->in[I_WIN], 10016, 7968, 1024, (bf16_t*)(ws + WS_WINAG), 1024, 4608, 2048, lds);
    conv_job(WV, A->in[I_WATTO], 1024, 0, 512, (bf16_t*)(ws + WS_WATTO), 512, 0, 1024, lds);
    conv_job(WV, A->in[I_WRWO], 1024, 0, 1024, (bf16_t*)(ws + WS_WRWO), 1024, 0, 1024, lds);
    conv_job(WV, A->in[I_WO], 1024, 0, 1024, (bf16_t*)(ws + WS_WO), 1024, 0, 1024, lds);
    { unsigned* z = (unsigned*)(ws + WS_WINRW + (size_t)3360 * 1024 * 2); for (size_t i = gtid; i < (size_t)224 * 512; i += gsz) z[i] = 0u; }
    { bf16_t* wl = (bf16_t*)(ws + WS_WLORA); const float* w2 = A->in[I_W2]; const float* a2 = A->in[I_A2]; const float* g2 = A->in[I_G2];
      for (size_t i = gtid; i < (size_t)384 * 3072; i += gsz) { const int k = (int)(i / 3072), n = (int)(i % 3072), seg = n >> 10, nn = n & 1023; float v = 0.f;
          if (seg == 0) { if (k < 64) v = w2[k * 1024 + nn]; } else if (seg == 1) { if (k >= 64 && k < 128) v = a2[(k - 64) * 1024 + nn]; } else { if (k >= 128 && k < 288) v = g2[(k - 128) * 1024 + nn]; }
          wl[(size_t)n * 384 + k] = f2bf(v); } }
    { float* ada = (float*)(ws + WS_ADA); const float* cc = A->in[I_C]; const float* wa = A->in[I_WADA]; const float* ba = A->in[I_BADA]; LAS float* red = (LAS float*)lds;
      for (int item = blockIdx.x; item < 192; item += G) {
          const int cl = tid & 31, ks = tid >> 5, col = item * 32 + cl; float ac[8];
#pragma unroll
          for (int b = 0; b < 8; ++b) ac[b] = 0.f;
          for (int k = ks * 64; k < ks * 64 + 64; ++k) { const float w = wa[(size_t)k * 6144 + col];
#pragma unroll
              for (int b = 0; b < 8; ++b) ac[b] = fmaf(cc[b * 1024 + k], w, ac[b]); }
#pragma unroll
          for (int b = 0; b < 8; ++b) red[(ks * 8 + b) * 32 + cl] = ac[b];
          __syncthreads();
          if (tid < 256) { const int b = tid >> 5; float s = 0.f;
#pragma unroll
              for (int q = 0; q < 16; ++q) s += red[(q * 8 + b) * 32 + cl];
              ada[b * 6144 + col] = s + ba[col]; }
          __syncthreads();
      } }
}

__device__ __forceinline__ void p_ffn_weights(const int WV, kargs_t A, lds_t lds) {
    unsigned char* ws = A->ws;
    conv_job(WV, A->in[I_WUP], 5632, 0, 1024, (bf16_t*)(ws + WS_WUP), 1024, 0, 5632, lds);
    conv_job(WV, A->in[I_WDN], 1024, 0, 2816, (bf16_t*)(ws + WS_WDN), 2816, 0, 1024, lds);
}
template <bool ADA, bool OUTBF>
__device__ __forceinline__ void norm_rows(const int WV, const float* src, const float* w, const float* ada_sh, const float* ada_sc, void* dst, int nrows, int row0g) {
    const int tid_ = ltid(); const int lane = tid_ & 63, wid = tid_ >> 6;
    const int nw = gridDim.x * 8, gw = blockIdx.x * 8 + wid;
    const int per = (nrows + nw - 1) / nw, r_begin = gw * per, r_end = (r_begin + per < nrows) ? r_begin + per : nrows;
    f32x4 cw[4], cs[4], vn[4]; int cb = -1;
    if (r_begin < r_end) {
#pragma unroll
        for (int i = 0; i < 4; ++i) vn[i] = *(const f32x4*)(src + (size_t)r_begin * 1024 + 4 * (lane + 64 * i)); }
    for (int r = r_begin; r < r_end; ++r) {
        const int b = (row0g + r) >> 12;
        if (b != cb) { cb = b;
#pragma unroll
            for (int i = 0; i < 4; ++i) { const int c = 4 * (lane + 64 * i); cw[i] = *(const f32x4*)(w + c);
                if constexpr (ADA) { const f32x4 sc = *(const f32x4*)(ada_sc + (size_t)b * 6144 + c); cw[i] = cw[i] * (sc + 1.0f); cs[i] = *(const f32x4*)(ada_sh + (size_t)b * 6144 + c); } } }
        f32x4 v[4]; float ss = 0.f;
#pragma unroll
        for (int i = 0; i < 4; ++i) v[i] = vn[i];
        if (r + 1 < r_end) { const float* pn = src + (size_t)(r + 1) * 1024;
#pragma unroll
            for (int i = 0; i < 4; ++i) vn[i] = *(const f32x4*)(pn + 4 * (lane + 64 * i)); }
#pragma unroll
        for (int i = 0; i < 4; ++i) ss += v[i][0] * v[i][0] + v[i][1] * v[i][1] + v[i][2] * v[i][2] + v[i][3] * v[i][3];
#pragma unroll
        for (int o = 32; o >= 1; o >>= 1) ss += __shfl_xor(ss, o);
        const float rs = rsqrtf(ss * (1.0f / 1024.0f) + 1e-6f);
#pragma unroll
        for (int i = 0; i < 4; ++i) { const int c = 4 * (lane + 64 * i); f32x4 y = v[i] * rs * cw[i];
            if constexpr (ADA) y = y + cs[i];
            if constexpr (OUTBF) { u32x2 o; o.x = pk_bf16(y[0], y[1]); o.y = pk_bf16(y[2], y[3]); *(u32x2*)((bf16_t*)dst + (size_t)r * 1024 + c) = o; }
            else *(f32x4*)((float*)dst + (size_t)r * 1024 + c) = y; }
    }
}

__device__ __forceinline__ void lora_prep(const int WV, kargs_t A) {
    const bf16_t* prw = (const bf16_t*)(A->ws + WS_PRW); bf16_t* al = (bf16_t*)(A->ws + WS_ALORA); const float* mu = A->in[I_MU] + 3072;
    const size_t gtid = (size_t)blockIdx.x * NTHREADS + ltid(), gsz = (size_t)gridDim.x * NTHREADS;
    for (size_t it = gtid; it < (size_t)MTOK * 48; it += gsz) {
        const int row = (int)(it / 48), ch = (int)(it % 48); u32x4 o = (u32x4){0u, 0u, 0u, 0u};
        if (ch < 36) {
            const bf16_t* p = prw + (size_t)row * NRW + 3072 + ch * 8;
            const u32x4 cu = *(const u32x4*)p; u32x4 pv = (u32x4){0u, 0u, 0u, 0u}; if ((row & 4095) != 0) pv = *(const u32x4*)(p - NRW);
            const f32x4 m0 = *(const f32x4*)(mu + ch * 8), m1 = *(const f32x4*)(mu + ch * 8 + 4);
            float z[8], zp[8];
            z[0] = bf_lo(cu.x); z[1] = bf_hi(cu.x); z[2] = bf_lo(cu.y); z[3] = bf_hi(cu.y); z[4] = bf_lo(cu.z); z[5] = bf_hi(cu.z); z[6] = bf_lo(cu.w); z[7] = bf_hi(cu.w);
            zp[0] = bf_lo(pv.x); zp[1] = bf_hi(pv.x); zp[2] = bf_lo(pv.y); zp[3] = bf_hi(pv.y); zp[4] = bf_lo(pv.z); zp[5] = bf_hi(pv.z); zp[6] = bf_lo(pv.w); zp[7] = bf_hi(pv.w);
#pragma unroll
            for (int j = 0; j < 8; ++j) { const float m = j < 4 ? m0[j & 3] : m1[j & 3]; float s = z[j] + (zp[j] - z[j]) * m;
                if (ch < 8) s = tanhf(s); else if (ch >= 16) s = sigm(s);
                z[j] = s; }
            o.x = pk_bf16(z[0], z[1]); o.y = pk_bf16(z[2], z[3]); o.z = pk_bf16(z[4], z[5]); o.w = pk_bf16(z[6], z[7]);
        }
        *(u32x4*)(al + (size_t)row * 384 + ch * 8) = o;
    }
}

__device__ __forceinline__ float allred8(float x) { x += dppf<0xB1>(x); x += dppf<0x4E>(x); x += dppf<0x141>(x); return x; }
__device__ __forceinline__ void scan_phase(const int WV, kargs_t A, lds_t lds) {
    const bf16_t* prw = (const bf16_t*)(A->ws + WS_PRW); const bf16_t* ea = (const bf16_t*)(A->ws + WS_EA);
    bf16_t* Y = (bf16_t*)(A->ws + WS_Y); float* BS = (float*)(A->ws + WS_BS);
    LAS float* L = (LAS float*)lds;
    LAS float* SY = L + 22528;
    const int tid = ltid(); const bool scanw = (WV < 4);
    const int ltd = tid & 255, r8 = ltd >> 3, k8 = ltd & 7;
    for (int item = blockIdx.x; item < 256; item += gridDim.x) {
        const int half = (item >> 3) & 1, pair = ((item >> 4) << 3) | (item & 7), h = pair & 15, b = pair >> 4;
        const int cr = h * 64 + 8 * k8, cv = h * 64 + half * 32 + 4 * k8;
        f32x4 cmur[2], cmuk[2], ckkv[2], ckav[2], crkv[2];
#pragma unroll
        for (int q = 0; q < 2; ++q) { cmur[q] = *(const f32x4*)(A->in[I_MU] + cr + 4 * q); cmuk[q] = *(const f32x4*)(A->in[I_MU] + 1024 + cr + 4 * q);
            ckkv[q] = *(const f32x4*)(A->in[I_KK] + cr + 4 * q); ckav[q] = *(const f32x4*)(A->in[I_KA] + cr + 4 * q); crkv[q] = *(const f32x4*)(A->in[I_RK] + cr + 4 * q); }
        const f32x4 cmuv = *(const f32x4*)(A->in[I_MU] + 2048 + cv);
        auto produce = [&](const int cc, const int bufi) {
            const int t = cc * 32 + r8; const size_t row = (size_t)b * SEQ + t; const bf16_t* pr = prw + row * NRW; const bf16_t* pp = (t > 0) ? pr - NRW : pr;
            const u32x4 ur = *(const u32x4*)(pr + cr), uk = *(const u32x4*)(pr + 1024 + cr); u32x4 urp = *(const u32x4*)(pp + cr), ukp = *(const u32x4*)(pp + 1024 + cr);
            const u32x2 uv = *(const u32x2*)(pr + 2048 + cv); u32x2 uvp = *(const u32x2*)(pp + 2048 + cv);
            const u32x4 ue = *(const u32x4*)(ea + row * 2048 + cr), ua = *(const u32x4*)(ea + row * 2048 + 1024 + cr);
            if (t == 0) { urp = (u32x4){0u, 0u, 0u, 0u}; ukp = (u32x4){0u, 0u, 0u, 0u}; uvp = (u32x2){0u, 0u}; }
            const float zr[8] = {bf_lo(ur.x), bf_hi(ur.x), bf_lo(ur.y), bf_hi(ur.y), bf_lo(ur.z), bf_hi(ur.z), bf_lo(ur.w), bf_hi(ur.w)};
            const float zrp[8] = {bf_lo(urp.x), bf_hi(urp.x), bf_lo(urp.y), bf_hi(urp.y), bf_lo(urp.z), bf_hi(urp.z), bf_lo(urp.w), bf_hi(urp.w)};
            const float zk[8] = {bf_lo(uk.x), bf_hi(uk.x), bf_lo(uk.y), bf_hi(uk.y), bf_lo(uk.z), bf_hi(uk.z), bf_lo(uk.w), bf_hi(uk.w)};
            const float zkp[8] = {bf_lo(ukp.x), bf_hi(ukp.x), bf_lo(ukp.y), bf_hi(ukp.y), bf_lo(ukp.z), bf_hi(ukp.z), bf_lo(ukp.w), bf_hi(ukp.w)};
            const float ze[8] = {bf_lo(ue.x), bf_hi(ue.x), bf_lo(ue.y), bf_hi(ue.y), bf_lo(ue.z), bf_hi(ue.z), bf_lo(ue.w), bf_hi(ue.w)};
            const float za[8] = {bf_lo(ua.x), bf_hi(ua.x), bf_lo(ua.y), bf_hi(ua.y), bf_lo(ua.z), bf_hi(ua.z), bf_lo(ua.w), bf_hi(ua.w)};
            float r_[8], k_[8], e_[8], a_[8], kk_[8]; float n2 = 0.f;
#pragma unroll
            for (int i = 0; i < 8; ++i) {
                r_[i] = zr[i] + (zrp[i] - zr[i]) * cmur[i >> 2][i & 3]; k_[i] = zk[i] + (zkp[i] - zk[i]) * cmuk[i >> 2][i & 3];
                e_[i] = ze[i]; a_[i] = za[i];
                kk_[i] = k_[i] * ckkv[i >> 2][i & 3]; n2 = fmaf(kk_[i], kk_[i], n2); }
            n2 = allred8(n2); const float inv = __builtin_amdgcn_rcpf(fmaxf(__builtin_amdgcn_sqrtf(n2), 1e-12f));
            float o_r[8], o_w[8], o_k[8], o_a[8], o_b[8]; float bsum = 0.f;
#pragma unroll
            for (int i = 0; i < 8; ++i) { const float kn = kk_[i] * inv; const float km = k_[i] * (1.0f + (a_[i] - 1.0f) * ckav[i >> 2][i & 3]);
                o_r[i] = r_[i]; o_w[i] = __expf(-e_[i]); o_k[i] = km; o_a[i] = -kn; o_b[i] = kn * a_[i]; bsum = fmaf(r_[i] * km, crkv[i >> 2][i & 3], bsum); }
            bsum = allred8(bsum);
            LAS float* Bf = L + bufi * 11264 + r8 * 64 + 8 * k8;
#pragma unroll
            for (int q = 0; q < 2; ++q) {
                *(LAS f32x4*)(Bf + 4 * q) = (f32x4){o_r[4 * q], o_r[4 * q + 1], o_r[4 * q + 2], o_r[4 * q + 3]};
                *(LAS f32x4*)(Bf + 2048 + 4 * q) = (f32x4){o_w[4 * q], o_w[4 * q + 1], o_w[4 * q + 2], o_w[4 * q + 3]};
                *(LAS f32x4*)(Bf + 4096 + 4 * q) = (f32x4){o_k[4 * q], o_k[4 * q + 1], o_k[4 * q + 2], o_k[4 * q + 3]};
                *(LAS f32x4*)(Bf + 6144 + 4 * q) = (f32x4){o_a[4 * q], o_a[4 * q + 1], o_a[4 * q + 2], o_a[4 * q + 3]};
                *(LAS f32x4*)(Bf + 8192 + 4 * q) = (f32x4){o_b[4 * q], o_b[4 * q + 1], o_b[4 * q + 2], o_b[4 * q + 3]}; }
            { const float v0 = bf_lo(uv.x), v1 = bf_hi(uv.x), v2 = bf_lo(uv.y), v3 = bf_hi(uv.y);
              *(LAS f32x4*)(L + bufi * 11264 + 10240 + r8 * 32 + 4 * k8) = (f32x4){v0 + (bf_lo(uvp.x) - v0) * cmuv[0], v1 + (bf_hi(uvp.x) - v1) * cmuv[1], v2 + (bf_lo(uvp.y) - v2) * cmuv[2], v3 + (bf_hi(uvp.y) - v3) * cmuv[3]}; }
            if (half == 0 && k8 == 0) BS[row * 16 + h] = bsum;
        };
        auto ystore = [&](const int cc) {
            const LAS float* syr = SY + (cc % 3) * 1024 + r8 * 32 + 4 * k8; const f32x4 yv = *(const LAS f32x4*)syr;
            u32x2 w; w.x = pk_bf16(yv[0], yv[1]); w.y = pk_bf16(yv[2], yv[3]);
            *(u32x2*)(Y + ((size_t)(b * 16 + h) * 4096 + cc * 32 + r8) * 64 + half * 32 + 4 * k8) = w;
        };
        __syncthreads();
        if (!scanw) produce(0, 0);
        __syncthreads();
        f32x2 S0 = {0.f, 0.f}, S1 = {0.f, 0.f}, S2 = {0.f, 0.f}, S3 = {0.f, 0.f};
        float yq = 0.f, yreg = 0.f;
        struct StepIn { f32x4 r0, r1, w0, w1, k0, k1, a0, a1, b0, b1; float v; };
#define SCAN_LDS(R, t) do { const unsigned ab_ = (unsigned)(size_t)(Bc + (t) * 64 + 8 * k8), av_ = (unsigned)(size_t)(Bc + (t) * 32 + r8); \
            asm volatile("ds_read_b128 %0, %11 offset:24576\n\tds_read_b128 %1, %11 offset:24592\n\tds_read_b128 %2, %11 offset:32768\n\tds_read_b128 %3, %11 offset:32784\n\t" \
                         "ds_read_b32 %10, %12 offset:40960\n\tds_read_b128 %4, %11 offset:16384\n\tds_read_b128 %5, %11 offset:16400\n\t" \
                         "ds_read_b128 %6, %11 offset:8192\n\tds_read_b128 %7, %11 offset:8208\n\tds_read_b128 %8, %11\n\tds_read_b128 %9, %11 offset:16" \
                         : "=&v"(R.a0), "=&v"(R.a1), "=&v"(R.b0), "=&v"(R.b1), "=&v"(R.k0), "=&v"(R.k1), "=&v"(R.w0), "=&v"(R.w1), "=&v"(R.r0), "=&v"(R.r1), "=&v"(R.v) : "v"(ab_), "v"(av_) : "memory"); } while (0)
#define SCAN_WAIT(R) asm volatile("s_waitcnt lgkmcnt(11)" : "+v"(R.a0), "+v"(R.a1), "+v"(R.b0), "+v"(R.b1), "+v"(R.k0), "+v"(R.k1), "+v"(R.w0), "+v"(R.w1), "+v"(R.r0), "+v"(R.r1), "+v"(R.v) :: "memory")
#define P2(v4, i) ((f32x2){v4[2 * (i)], v4[2 * (i) + 1]})
#define SCAN_STEP(R, t) do { \
            f32x2 pa = S0 * P2(R.a0, 0), pb = S1 * P2(R.a0, 1); pa = S2 * P2(R.a1, 0) + pa; pb = S3 * P2(R.a1, 1) + pb; \
            float sa = (pa.x + pb.x) + (pa.y + pb.y); float yy = yq; \
            sa += dppf<0xB1>(sa); yy += dppf<0xB1>(yy); sa += dppf<0x4E>(sa); yy += dppf<0x4E>(yy); sa += dppf<0x141>(sa); yy += dppf<0x141>(yy); \
            yreg = (k8 == (((t) + 7) & 7)) ? yy : yreg; \
            const f32x2 sa2 = {sa, sa}, vv2 = {R.v, R.v}; \
            f32x2 t0 = vv2 * P2(R.k0, 0), t1 = vv2 * P2(R.k0, 1), t2 = vv2 * P2(R.k1, 0), t3 = vv2 * P2(R.k1, 1); \
            t0 = sa2 * P2(R.b0, 0) + t0; t1 = sa2 * P2(R.b0, 1) + t1; t2 = sa2 * P2(R.b1, 0) + t2; t3 = sa2 * P2(R.b1, 1) + t3; \
            S0 = S0 * P2(R.w0, 0) + t0; S1 = S1 * P2(R.w0, 1) + t1; S2 = S2 * P2(R.w1, 0) + t2; S3 = S3 * P2(R.w1, 1) + t3; \
            f32x2 qa = S0 * P2(R.r0, 0); qa = S1 * P2(R.r0, 1) + qa; qa = S2 * P2(R.r1, 0) + qa; qa = S3 * P2(R.r1, 1) + qa; \
            yq = qa.x + qa.y; } while (0)
        for (int c = 0; c < 128; ++c) {
            if (scanw) {
                const LAS float* Bc = L + (c & 1) * 11264;
                LAS float* syc = SY + (c % 3) * 1024; LAS float* syp = SY + ((c + 2) % 3) * 1024;
                StepIn R0, R1;
                SCAN_LDS(R0, 0);
#pragma unroll 4
                for (int t = 0; t < 32; t += 2) {
                    SCAN_LDS(R1, t + 1); SCAN_WAIT(R0); SCAN_STEP(R0, t);
                    if ((t & 7) == 0) { if (t == 0) { if (c > 0) syp[(24 + k8) * 32 + r8] = yreg; } else syc[(t - 8 + k8) * 32 + r8] = yreg; }
                    SCAN_LDS(R0, (t + 2) & 31); SCAN_WAIT(R1); SCAN_STEP(R1, t + 1);
                }
                asm volatile("s_waitcnt lgkmcnt(0)" : "+v"(R0.a0), "+v"(R0.a1), "+v"(R0.b0), "+v"(R0.b1), "+v"(R0.k0), "+v"(R0.k1), "+v"(R0.w0), "+v"(R0.w1), "+v"(R0.r0), "+v"(R0.r1), "+v"(R0.v) :: "memory");
            } else {
                if (c >= 2) ystore(c - 2);
                if (c + 1 < 128) produce(c + 1, (c + 1) & 1);
            }
            __syncthreads();
        }
        if (scanw) { const float yy = allred8(yq); yreg = (k8 == 7) ? yy : yreg; SY[(127 % 3) * 1024 + (24 + k8) * 32 + r8] = yreg; }
        __syncthreads();
        if (!scanw) { ystore(126); ystore(127); }
#undef SCAN_LDS
#undef SCAN_STEP
#undef P2
    }
}

__device__ __forceinline__ void post_phase(const int WV, kargs_t A) {
    const bf16_t* prw = (const bf16_t*)(A->ws + WS_PRW); const bf16_t* Y = (const bf16_t*)(A->ws + WS_Y); const bf16_t* Gg = (const bf16_t*)(A->ws + WS_G);
    const float* BS = (const float*)(A->ws + WS_BS); bf16_t* RWO = (bf16_t*)(A->ws + WS_RWO);
    const size_t gtid = (size_t)blockIdx.x * NTHREADS + ltid(), gsz = (size_t)gridDim.x * NTHREADS;
    constexpr int RR = 64;
    for (size_t it = gtid; it < (size_t)(MTOK / RR) * 256; it += gsz) {
        const int cg = (int)(it & 255), h = cg >> 4, kq = cg & 15, c = 4 * cg; const size_t row0 = (it >> 8) * RR; const int b = (int)(row0 >> 12), t0 = (int)(row0 & 4095);
        const f32x4 muv = *(const f32x4*)(A->in[I_MU] + 2048 + c), lw = *(const f32x4*)(A->in[I_LNW] + c), lb = *(const f32x4*)(A->in[I_LNB] + c);
        const bf16_t* yp = Y + ((size_t)(b * 16 + h) * 4096 + t0) * 64 + 4 * kq;
        u32x2 vp = (u32x2){0u, 0u}; if (t0 != 0) vp = *(const u32x2*)(prw + (row0 - 1) * NRW + 2048 + c);
#pragma unroll 4
        for (int rr = 0; rr < RR; ++rr) {
            const size_t row = row0 + rr;
            const u32x2 yu = *(const u32x2*)(yp + (size_t)rr * 64); const u32x2 vu = *(const u32x2*)(prw + row * NRW + 2048 + c);
            const u32x2 gu = *(const u32x2*)(Gg + row * 1024 + c); const float bs = BS[row * 16 + h];
            float y[4] = {bf_lo(yu.x), bf_hi(yu.x), bf_lo(yu.y), bf_hi(yu.y)};
            const float mean = allred16((y[0] + y[1]) + (y[2] + y[3])) * (1.0f / 64.0f);
            float q = 0.f;
#pragma unroll
            for (int i = 0; i < 4; ++i) { y[i] -= mean; q = fmaf(y[i], y[i], q); }
            const float rstd = rsqrtf(allred16(q) * (1.0f / 64.0f) + 64e-5f);
            const float vc[4] = {bf_lo(vu.x), bf_hi(vu.x), bf_lo(vu.y), bf_hi(vu.y)}, vq[4] = {bf_lo(vp.x), bf_hi(vp.x), bf_lo(vp.y), bf_hi(vp.y)}, gg[4] = {bf_lo(gu.x), bf_hi(gu.x), bf_lo(gu.y), bf_hi(gu.y)};
            float o[4];
#pragma unroll
            for (int i = 0; i < 4; ++i) { const float v = vc[i] + (vq[i] - vc[i]) * muv[i]; o[i] = (y[i] * rstd * lw[i] + lb[i] + bs * v) * gg[i]; }
            u32x2 w; w.x = pk_bf16(o[0], o[1]); w.y = pk_bf16(o[2], o[3]); *(u32x2*)(RWO + row * 1024 + c) = w;
            vp = vu;
        }
    }
}

__device__ __forceinline__ void attn_phase(const int WV, kargs_t A, lds_t lds) {
    const bf16_t* PATT = (const bf16_t*)(A->ws + WS_PATT); bf16_t* ATTO = (bf16_t*)(A->ws + WS_ATTO); float* LSE = (float*)(A->ws + WS_LSE);
    lds_t Ks = lds; lds_t Vt = lds + 36864;
    const int tid = ltid(), wid = tid >> 6, lane = tid & 63, fr = lane & 15, fq = lane >> 4, T0 = wid & ~1;
    u32x4 pk_[4], pv_[4]; bf16x8 pq_[2];
#define ATT_DECODE(u) const int idx = (u) & 31, h = ((u) >> 5) & 7, gb = (u) >> 8, g = gb % 3, bl = gb / 3; \
        const int dl = (g == 0) ? 0 : (g == 1 ? 2 : 4); const int r = idx & ((1 << dl) - 1), n = idx >> dl; \
        const bf16_t* base = PATT + (size_t)(bl * SEQ) * 4608 + g * 1536 + h * 64;
#define ATT_LOAD(u) do { ATT_DECODE(u) \
        _Pragma("unroll") for (int i = 0; i < 4; ++i) { const int c = tid + 512 * i, key = c >> 3, part = c & 7; int j = 128 * n - 128 + key; j = j < 0 ? 0 : j; const size_t pos = ((size_t)j << dl) + r; \
            pk_[i] = *(const u32x4*)(base + pos * 4608 + 512 + part * 8); pv_[i] = *(const u32x4*)(base + pos * 4608 + 1024 + part * 8); } \
        { const int qi_ = 16 * wid + fr; const size_t pos = ((size_t)(128 * n + qi_) << dl) + r; pq_[0] = *(const bf16x8*)(base + pos * 4608 + fq * 8); pq_[1] = *(const bf16x8*)(base + pos * 4608 + 32 + fq * 8); } } while (0)
    if ((int)blockIdx.x < 3072) ATT_LOAD((int)blockIdx.x);
    for (int u = blockIdx.x; u < 3072; u += gridDim.x) {
        ATT_DECODE(u) (void)base;
        __syncthreads();
#pragma unroll
        for (int i = 0; i < 4; ++i) { const int c = tid + 512 * i, key = c >> 3, part = c & 7;
            *(LAS u32x4*)(Ks + key * 144 + part * 16) = pk_[i];
            *(LAS u32x4*)(Vt + key * 144 + part * 16) = pv_[i]; }
        const int qi = 16 * wid + fr; bf16x8 qf[2]; qf[0] = pq_[0]; qf[1] = pq_[1];
        __syncthreads();
        if (u + (int)gridDim.x < 3072) ATT_LOAD(u + (int)gridDim.x);
        f32x4 st[10]; float m = -INFINITY;
#pragma unroll
        for (int T = 0; T < 10; ++T) { const int Tt = T0 + T;
            const bf16x8 k0 = *(const LAS bf16x8*)(Ks + (16 * Tt + fr) * 144 + fq * 16), k1 = *(const LAS bf16x8*)(Ks + (16 * Tt + fr) * 144 + 64 + fq * 16);
            f32x4 acc = (f32x4){0.f, 0.f, 0.f, 0.f};
            acc = __builtin_amdgcn_mfma_f32_16x16x32_bf16(k0, qf[0], acc, 0, 0, 0); acc = __builtin_amdgcn_mfma_f32_16x16x32_bf16(k1, qf[1], acc, 0, 0, 0);
            const int rel = Tt - wid;
            if (rel < 0 || rel > 8 || (n == 0 && Tt < 8)) { acc = (f32x4){-INFINITY, -INFINITY, -INFINITY, -INFINITY}; }
            else if (rel == 0) {
#pragma unroll
                for (int rg = 0; rg < 4; ++rg) { const float s = (4 * fq + rg >= fr) ? acc[rg] * 0.125f : -INFINITY; acc[rg] = s; m = fmaxf(m, s); } }
            else if (rel == 8) {
#pragma unroll
                for (int rg = 0; rg < 4; ++rg) { const float s = (4 * fq + rg <= fr) ? acc[rg] * 0.125f : -INFINITY; acc[rg] = s; m = fmaxf(m, s); } }
            else {
#pragma unroll
                for (int rg = 0; rg < 4; ++rg) { const float s = acc[rg] * 0.125f; acc[rg] = s; m = fmaxf(m, s); } }
            st[T] = acc; }
        m = fmaxf(m, __shfl_xor(m, 16)); m = fmaxf(m, __shfl_xor(m, 32));
        float den = 0.f;
#pragma unroll
        for (int T = 0; T < 10; ++T)
#pragma unroll
            for (int rg = 0; rg < 4; ++rg) { const float p = __expf(st[T][rg] - m); st[T][rg] = p; den += p; }
        den += __shfl_xor(den, 16); den += __shfl_xor(den, 32);
        f32x4 o[4];
#pragma unroll
        for (int nt = 0; nt < 4; ++nt) o[nt] = (f32x4){0.f, 0.f, 0.f, 0.f};
        const unsigned vaddr = (unsigned)(size_t)Vt + (unsigned)((4 * fq + (fr >> 2)) * 144 + (fr & 3) * 8);
#pragma unroll
        for (int s2 = 0; s2 < 5; ++s2) { const int Ta = T0 + 2 * s2;
            u32x4 pw; pw.x = pk_bf16(st[2 * s2][0], st[2 * s2][1]); pw.y = pk_bf16(st[2 * s2][2], st[2 * s2][3]); pw.z = pk_bf16(st[2 * s2 + 1][0], st[2 * s2 + 1][1]); pw.w = pk_bf16(st[2 * s2 + 1][2], st[2 * s2 + 1][3]);
            const bf16x8 pa = __builtin_bit_cast(bf16x8, pw);
            const unsigned va = vaddr + (unsigned)(16 * Ta * 144);
            u32x2 a0, a1, a2, a3, b0, b1, b2, b3;
            asm volatile("ds_read_b64_tr_b16 %0, %8\n\tds_read_b64_tr_b16 %1, %8 offset:32\n\tds_read_b64_tr_b16 %2, %8 offset:64\n\tds_read_b64_tr_b16 %3, %8 offset:96\n\t"
                         "ds_read_b64_tr_b16 %4, %8 offset:2304\n\tds_read_b64_tr_b16 %5, %8 offset:2336\n\tds_read_b64_tr_b16 %6, %8 offset:2368\n\tds_read_b64_tr_b16 %7, %8 offset:2400\n\t"
                         "s_waitcnt lgkmcnt(0)"
                         : "=&v"(a0), "=&v"(a1), "=&v"(a2), "=&v"(a3), "=&v"(b0), "=&v"(b1), "=&v"(b2), "=&v"(b3) : "v"(va) : "memory");
            { u32x4 vw; vw.x = a0.x; vw.y = a0.y; vw.z = b0.x; vw.w = b0.y; o[0] = __builtin_amdgcn_mfma_f32_16x16x32_bf16(pa, __builtin_bit_cast(bf16x8, vw), o[0], 0, 0, 0); }
            { u32x4 vw; vw.x = a1.x; vw.y = a1.y; vw.z = b1.x; vw.w = b1.y; o[1] = __builtin_amdgcn_mfma_f32_16x16x32_bf16(pa, __builtin_bit_cast(bf16x8, vw), o[1], 0, 0, 0); }
            { u32x4 vw; vw.x = a2.x; vw.y = a2.y; vw.z = b2.x; vw.w = b2.y; o[2] = __builtin_amdgcn_mfma_f32_16x16x32_bf16(pa, __builtin_bit_cast(bf16x8, vw), o[2], 0, 0, 0); }
            { u32x4 vw; vw.x = a3.x; vw.y = a3.y; vw.z = b3.x; vw.w = b3.y; o[3] = __builtin_amdgcn_mfma_f32_16x16x32_bf16(pa, __builtin_bit_cast(bf16x8, vw), o[3], 0, 0, 0); } }
        const float inv = __builtin_amdgcn_rcpf(den);
        if (fq == 0) { const size_t pos = ((size_t)(128 * n + qi) << dl) + r; LSE[((size_t)g * CH + (size_t)bl * SEQ + pos) * 8 + h] = m + __logf(den); }
#pragma unroll
        for (int rg = 0; rg < 4; ++rg) { const float iv = __shfl(inv, 4 * fq + rg); const int q = 16 * wid + 4 * fq + rg; const size_t pos = ((size_t)(128 * n + q) << dl) + r;
            bf16_t* op = ATTO + ((size_t)g * CH + (size_t)bl * SEQ + pos) * 512 + h * 64 + fr;
#pragma unroll
            for (int nt = 0; nt < 4; ++nt) op[16 * nt] = f2bf(o[nt][rg] * iv); }
    }
#undef ATT_DECODE
#undef ATT_LOAD
}

__device__ __forceinline__ void combine_phase(const int WV, kargs_t A, const size_t roff, const size_t it0, const size_t it1, const int blk0, const int nblk) {
    const bf16_t* ATTO = (const bf16_t*)(A->ws + WS_ATTO); const float* LSE = (const float*)(A->ws + WS_LSE); bf16_t* ATTM = (bf16_t*)(A->ws + WS_ATTM) + roff * 512;
    if ((int)blockIdx.x < blk0 || (int)blockIdx.x >= blk0 + nblk) return;
    const size_t gtid = (size_t)((int)blockIdx.x - blk0) * NTHREADS + ltid(), gsz = (size_t)nblk * NTHREADS;
    for (size_t it = it0 + gtid; it < it1; it += gsz) {
        const size_t row = it >> 6; const int ch = (int)(it & 63), h = ch >> 3;
        const float l0 = LSE[(0 * (size_t)CH + row) * 8 + h], l1 = LSE[(1 * (size_t)CH + row) * 8 + h], l2 = LSE[(2 * (size_t)CH + row) * 8 + h];
        const float mx = fmaxf(l0, fmaxf(l1, l2)); float w0 = __expf(l0 - mx), w1 = __expf(l1 - mx), w2 = __expf(l2 - mx); const float is = __builtin_amdgcn_rcpf(w0 + w1 + w2); w0 *= is; w1 *= is; w2 *= is;
        const u32x4 a0 = *(const u32x4*)(ATTO + (0 * (size_t)CH + row) * 512 + ch * 8), a1 = *(const u32x4*)(ATTO + (1 * (size_t)CH + row) * 512 + ch * 8), a2 = *(const u32x4*)(ATTO + (2 * (size_t)CH + row) * 512 + ch * 8);
        u32x4 o;
        o.x = pk_bf16(w0 * bf_lo(a0.x) + w1 * bf_lo(a1.x) + w2 * bf_lo(a2.x), w0 * bf_hi(a0.x) + w1 * bf_hi(a1.x) + w2 * bf_hi(a2.x));
        o.y = pk_bf16(w0 * bf_lo(a0.y) + w1 * bf_lo(a1.y) + w2 * bf_lo(a2.y), w0 * bf_hi(a0.y) + w1 * bf_hi(a1.y) + w2 * bf_hi(a2.y));
        o.z = pk_bf16(w0 * bf_lo(a0.z) + w1 * bf_lo(a1.z) + w2 * bf_lo(a2.z), w0 * bf_hi(a0.z) + w1 * bf_hi(a1.z) + w2 * bf_hi(a2.z));
        o.w = pk_bf16(w0 * bf_lo(a0.w) + w1 * bf_lo(a1.w) + w2 * bf_lo(a2.w), w0 * bf_hi(a0.w) + w1 * bf_hi(a1.w) + w2 * bf_hi(a2.w));
        *(u32x4*)(ATTM + row * 512 + ch * 8) = o;
    }
}

constexpr int CONV_RS = 32;
__device__ __forceinline__ void halo_phase(const int WV, kargs_t A) {
    const bf16_t* U = (const bf16_t*)(A->ws + WS_U); bf16_t* HALO = (bf16_t*)(A->ws + WS_HALO);
    const size_t gtid = (size_t)blockIdx.x * NTHREADS + ltid(), gsz = (size_t)gridDim.x * NTHREADS;
    for (size_t it = gtid; it < (size_t)(MTOK / CONV_RS) * 2 * 704; it += gsz) {
        const int ch = (int)(it % 704); const size_t sr = it / 704; const int which = (int)(sr & 1); const size_t seg = sr >> 1; const size_t row0 = seg * CONV_RS;
        u32x4 v = (u32x4){0u, 0u, 0u, 0u};
        if ((row0 & 4095) != 0) v = *(const u32x4*)(U + (row0 - 1 - which) * 5632 + ch * 8);
        *(u32x4*)(HALO + (seg * 2 + which) * 5632 + ch * 8) = v;
    }
}
__device__ __forceinline__ void conv_phase(const int WV, kargs_t A, unsigned* bar, volatile LAS unsigned* bst, const bool one_launch) {
    bf16_t* U = (bf16_t*)(A->ws + WS_U); bf16_t* HALO = (bf16_t*)(A->ws + WS_HALO); const float* cw = A->in[I_CONVW]; const float* cb = A->in[I_CONVB];
    const size_t gtid = (size_t)blockIdx.x * NTHREADS + ltid(), gsz = (size_t)gridDim.x * NTHREADS;
    constexpr int R = CONV_RS; constexpr int MAXIT = 3;
    const size_t nitems = (size_t)(MTOK / R) * 352;
    const bool fits = nitems <= (size_t)MAXIT * gsz;
    if (one_launch && !fits) {
        for (size_t it = gtid; it < (size_t)(MTOK / R) * 2 * 704; it += gsz) { const int ch = (int)(it % 704); const size_t sr = it / 704; const int which = (int)(sr & 1); const size_t seg = sr >> 1; const size_t row0 = seg * R;
            u32x4 v = (u32x4){0u, 0u, 0u, 0u}; if ((row0 & 4095) != 0) v = *(const u32x4*)(U + (row0 - 1 - which) * 5632 + ch * 8);
            *(u32x4*)(HALO + (seg * 2 + which) * 5632 + ch * 8) = v; }
        xcd_barrier(WV, bar, bst);
    }
    const bool from_u = one_launch && fits;
    auto process = [&](const size_t it, const u32x4 (&hh1)[2], const u32x4 (&hh2)[2]) {
        const size_t seg = it / 352; const int j = (int)(it % 352) * 8; const size_t row0 = seg * R;
        f32x4 wb[2][2], w0[2][2], w1[2][2], w2[2][2];
#pragma unroll
        for (int s2 = 0; s2 < 2; ++s2)
#pragma unroll
            for (int q = 0; q < 2; ++q) { const int c = s2 * DFF + j + 4 * q; wb[s2][q] = *(const f32x4*)(cb + c); w0[s2][q] = *(const f32x4*)(cw + c); w1[s2][q] = *(const f32x4*)(cw + 5632 + c); w2[s2][q] = *(const f32x4*)(cw + 2 * 5632 + c); }
        u32x4 p1[2], p2[2];
#pragma unroll
        for (int s2 = 0; s2 < 2; ++s2) { p1[s2] = hh1[s2]; p2[s2] = hh2[s2]; }
#pragma unroll 4
        for (int rr = 0; rr < R; ++rr) {
            const size_t row = row0 + rr; u32x4 u0[2]; float res[2][8];
#pragma unroll
            for (int s2 = 0; s2 < 2; ++s2) u0[s2] = *(const u32x4*)(U + row * 5632 + s2 * DFF + j);
#pragma unroll
            for (int s2 = 0; s2 < 2; ++s2) {
                const float x0[8] = {bf_lo(u0[s2].x), bf_hi(u0[s2].x), bf_lo(u0[s2].y), bf_hi(u0[s2].y), bf_lo(u0[s2].z), bf_hi(u0[s2].z), bf_lo(u0[s2].w), bf_hi(u0[s2].w)};
                const float x1[8] = {bf_lo(p1[s2].x), bf_hi(p1[s2].x), bf_lo(p1[s2].y), bf_hi(p1[s2].y), bf_lo(p1[s2].z), bf_hi(p1[s2].z), bf_lo(p1[s2].w), bf_hi(p1[s2].w)};
                const float x2[8] = {bf_lo(p2[s2].x), bf_hi(p2[s2].x), bf_lo(p2[s2].y), bf_hi(p2[s2].y), bf_lo(p2[s2].z), bf_hi(p2[s2].z), bf_lo(p2[s2].w), bf_hi(p2[s2].w)};
#pragma unroll
                for (int q = 0; q < 2; ++q)
#pragma unroll
                    for (int i = 0; i < 4; ++i) res[s2][4 * q + i] = wb[s2][q][i] + w0[s2][q][i] * x2[4 * q + i] + w1[s2][q][i] * x1[4 * q + i] + w2[s2][q][i] * x0[4 * q + i];
                p2[s2] = p1[s2]; p1[s2] = u0[s2];
            }
            float o[8];
#pragma unroll
            for (int i = 0; i < 8; ++i) { const float gt = res[0][i]; o[i] = gt * sigm(gt) * res[1][i]; }
            u32x4 w; w.x = pk_bf16(o[0], o[1]); w.y = pk_bf16(o[2], o[3]); w.z = pk_bf16(o[4], o[5]); w.w = pk_bf16(o[6], o[7]);
            *(u32x4*)(U + row * 5632 + j) = w;
        }
    };
    auto load_halo = [&](const size_t it, u32x4 (&hh1)[2], u32x4 (&hh2)[2], const bool fu) {
        const size_t seg = it / 352; const int j = (int)(it % 352) * 8; const size_t row0 = seg * R;
#pragma unroll
        for (int s2 = 0; s2 < 2; ++s2) { hh1[s2] = (u32x4){0u, 0u, 0u, 0u}; hh2[s2] = (u32x4){0u, 0u, 0u, 0u};
            if (fu) { if ((row0 & 4095) != 0) { hh1[s2] = *(const u32x4*)(U + (row0 - 1) * 5632 + s2 * DFF + j); hh2[s2] = *(const u32x4*)(U + (row0 - 2) * 5632 + s2 * DFF + j); } }
            else { hh1[s2] = *(const u32x4*)(HALO + (seg * 2 + 0) * 5632 + s2 * DFF + j); hh2[s2] = *(const u32x4*)(HALO + (seg * 2 + 1) * 5632 + s2 * DFF + j); } }
    };
    u32x4 h1[MAXIT][2], h2[MAXIT][2];
#pragma unroll
    for (int k = 0; k < MAXIT; ++k) { const size_t it = gtid + (size_t)k * gsz; if (it < nitems) load_halo(it, h1[k], h2[k], from_u); }
    if (from_u) xcd_barrier(WV, bar, bst);
#pragma unroll
    for (int k = 0; k < MAXIT; ++k) { const size_t it = gtid + (size_t)k * gsz; if (it < nitems) process(it, h1[k], h2[k]); }
    for (size_t it = gtid + (size_t)MAXIT * gsz; it < nitems; it += gsz) { u32x4 a1[2], a2[2]; load_halo(it, a1, a2, false); process(it, a1, a2); }
}

template <int MODE> __device__ __forceinline__ void gemm_call(const int WV, lds_t lds, const pg8::Gemm g, const pg8::EpiArgs ea) {
    pg8::StaticOrder S; S.init(g.M, g.N, (int)gridDim.x, (int)blockIdx.x); pg8::Epi<MODE> E; E.a = ea; pg8::gemm_phase(WV, lds, g, S, E);
}
template <unsigned KM> __global__ void __launch_bounds__(NTHREADS, 2) fwd_kernel(Args Aval) {
    extern __shared__ __attribute__((aligned(16))) unsigned char lds_raw[];
    lds_t lds = (lds_t)lds_raw;
    const kargs_t A0 = (kargs_t)__builtin_amdgcn_kernarg_segment_ptr();
    const int WV = __builtin_amdgcn_readfirstlane(threadIdx.x >> 6);
    const int lo = A0->ph_lo, hi = A0->ph_hi; int ph = 0;
    unsigned* const bar = (unsigned*)(A0->ws + WS_BAR);
    volatile LAS unsigned* const bst = (volatile LAS unsigned*)(lds + 131072);
    if (hi > N_PHASES) cg::this_grid().sync();
    if (hi - lo > 1) {
        if (ltid() == 0) { bst[0] = 0u; bst[1] = 0u; (void)xb_add(&bar[XB_XCNT(xb_xcc_id())], 1u); }
        __syncthreads();
    }
    const int G = gridDim.x, bid = blockIdx.x;
#ifndef REP_MASK
#define REP_MASK 0u
#endif
#ifndef KIND_MASK
#define KIND_MASK 0xFFFFFFFFu
#endif
#define PH_BEGIN(k) if (ph >= lo && ph < hi) { if constexpr (((KM) >> (k)) & 1u) { for (int rep_ = 0; rep_ < ((((REP_MASK) >> (k)) & 1u) ? 2 : 1); ++rep_) { if (rep_) xcd_barrier(WV, bar, bst); const kargs_t A = launder_args(A0); unsigned char* const ws = A->ws; const float* const ada = (const float*)(ws + WS_ADA); (void)ada;
#define PH_END } } if (ph + 1 < hi) { xcd_barrier(WV, bar, bst); } } ++ph;
    using namespace pg8;
#ifdef PROBE_SYNCS
    if (hi - lo > 1) { for (int i_ = 0; i_ < PROBE_SYNCS; ++i_) cg::this_grid().sync(); }
#endif
    PH_BEGIN(0) p0_weights(WV, A, lds); PH_END
    PH_BEGIN(1) norm_rows<true, true>(WV, A->in[I_X], A->in[I_N1W], ada + 0, ada + 1024, ws + WS_H1, MTOK, 0); PH_END
    PH_BEGIN(2) { Gemm g{(const bf16_t*)(ws + WS_H1), (const bf16_t*)(ws + WS_WINRW), MTOK, NRW, 1024, 1024, 1024}; EpiArgs ea{}; ea.o0 = (bf16_t*)(ws + WS_PRW); ea.ld0 = NRW; ea.ncol0 = 1 << 30; gemm_call<EP_BF16>(WV, lds, g, ea); } PH_END
    PH_BEGIN(3) lora_prep(WV, A); PH_END
    PH_BEGIN(4) { Gemm g{(const bf16_t*)(ws + WS_ALORA), (const bf16_t*)(ws + WS_WLORA), MTOK, 2048, 256, 384, 384}; EpiArgs ea{}; ea.o0 = (bf16_t*)(ws + WS_EA); ea.ld0 = 2048; ea.p0 = A->in[I_W0]; ea.p1 = A->in[I_A0]; gemm_call<EP_EA>(WV, lds, g, ea); } PH_END
    PH_BEGIN(5) scan_phase(WV, A, lds); PH_END
    PH_BEGIN(6) { Gemm g{(const bf16_t*)(ws + WS_ALORA) + 128, (const bf16_t*)(ws + WS_WLORA) + (size_t)2048 * 384 + 128, MTOK, 1024, 256, 384, 384}; EpiArgs ea{}; ea.o0 = (bf16_t*)(ws + WS_G); ea.ld0 = 1024; ea.ncol0 = 1 << 30; gemm_call<EP_BF16>(WV, lds, g, ea); } PH_END
    PH_BEGIN(7) post_phase(WV, A); PH_END
    for (int ck = 0; ck < 2; ++ck) {
        const size_t roff = (size_t)ck * CH;
        if (ck == 0) { PH_BEGIN(8) norm_rows<true, true>(WV, A->in[I_X], A->in[I_N1W], ada + 0, ada + 1024, ws + WS_H1C, CH, 0); PH_END }
        PH_BEGIN(9) { Gemm g{(const bf16_t*)(ws + WS_H1C), (const bf16_t*)(ws + WS_WINAG), CH, NAG, 1024, 1024, 1024}; EpiArgs ea{}; ea.o0 = (bf16_t*)(ws + WS_PATT); ea.ld0 = 4608; ea.ncol0 = 4608; ea.o1 = (bf16_t*)(ws + WS_PGATE) + roff * 2048; ea.ld1 = 2048; gemm_call<EP_BF16>(WV, lds, g, ea); }
                    if (ck == 1) { const int nfull = ((CH / 256) * (NAG / 256)) % (int)gridDim.x; if (nfull) combine_phase(WV, A, 0, (size_t)CH * 32, (size_t)CH * 64, nfull, (int)gridDim.x - nfull); else combine_phase(WV, A, 0, (size_t)CH * 32, (size_t)CH * 64, 0, (int)gridDim.x); } PH_END
        PH_BEGIN(10) attn_phase(WV, A, lds); PH_END
        PH_BEGIN(11) combine_phase(WV, A, roff, 0, ck == 0 ? (size_t)CH * 32 : (size_t)CH * 64, 0, (int)gridDim.x);
                     if (ck == 0) norm_rows<true, true>(WV, A->in[I_X] + (size_t)CH * 1024, A->in[I_N1W], ada + 0, ada + 1024, ws + WS_H1C, CH, CH); PH_END
    }
    PH_BEGIN(12) { { Gemm g{(const bf16_t*)(ws + WS_ATTM), (const bf16_t*)(ws + WS_WATTO), MTOK, 1024, 512, 512, 512}; EpiArgs ea{}; ea.gate = (const bf16_t*)(ws + WS_PGATE); ea.p0 = A->in[I_BGATE]; ea.t1 = (float*)(ws + WS_T1); gemm_call<EP_ATTOUT>(WV, lds, g, ea); }
                   { Gemm g{(const bf16_t*)(ws + WS_RWO), (const bf16_t*)(ws + WS_WRWO), MTOK, 1024, 1024, 1024, 1024}; EpiArgs ea{}; ea.gate = (const bf16_t*)(ws + WS_PGATE); ea.p0 = A->in[I_BGATE]; ea.t1 = (float*)(ws + WS_T1); ea.o0 = (bf16_t*)(ws + WS_MIX); gemm_call<EP_RWOUT>(WV, lds, g, ea); } } PH_END
    PH_BEGIN(14) { Gemm g{(const bf16_t*)(ws + WS_MIX), (const bf16_t*)(ws + WS_WO), MTOK, 1024, 1024, 1024, 1024}; EpiArgs ea{}; ea.p0 = ada + 2048; ea.row0g = 0; ea.base = A->in[I_X]; ea.outf = A->out; gemm_call<EP_RESID>(WV, lds, g, ea); } PH_END
    PH_BEGIN(15) p_ffn_weights(WV, A, lds);
                 norm_rows<true, true>(WV, A->out, A->in[I_N2W], ada + 3072, ada + 4096, ws + WS_H2, MTOK, 0); PH_END
    PH_BEGIN(16) { Gemm g{(const bf16_t*)(ws + WS_H2), (const bf16_t*)(ws + WS_WUP), MTOK, 5632, 1024, 1024, 1024}; EpiArgs ea{}; ea.o0 = (bf16_t*)(ws + WS_U); ea.ld0 = 5632; ea.ncol0 = 1 << 30; gemm_call<EP_BF16>(WV, lds, g, ea); } PH_END
#if !MK_ONE_LAUNCH
    PH_BEGIN(13) halo_phase(WV, A); PH_END
#endif
    PH_BEGIN(17) conv_phase(WV, A, bar, bst, MK_ONE_LAUNCH != 0); PH_END
    PH_BEGIN(18) { Gemm g{(const bf16_t*)(ws + WS_U), (const bf16_t*)(ws + WS_WDN), MTOK, 1024, DFF, 5632, DFF}; EpiArgs ea{}; ea.p0 = ada + 5120; ea.row0g = 0; ea.base = A->out; ea.outf = A->out; gemm_call<EP_RESID>(WV, lds, g, ea); } PH_END
    PH_BEGIN(19) norm_rows<false, false>(WV, A->out, A->in[I_NFW], nullptr, nullptr, A->out, MTOK, 0); PH_END
#undef PH_BEGIN
#undef PH_END
}

constexpr unsigned LIGHT_MASK = (1u << 0) | (1u << 1) | (1u << 3) | (1u << 7) | (1u << 8) | (1u << 11) | (1u << 13) | (1u << 15) | (1u << 17) | (1u << 19);
#if MK_ONE_LAUNCH
static const int kind_of_phase[N_PHASES] = {0, 1, 2, 3, 4, 5, 6, 7, 8, 9, 10, 11, 9, 10, 11, 12, 14, 15, 16, 17, 18, 19};
#else
static const int kind_of_phase[N_PHASES] = {0, 1, 2, 3, 4, 5, 6, 7, 8, 9, 10, 11, 9, 10, 11, 12, 14, 15, 16, 13, 17, 18, 19};
#endif
typedef void (*kfn_t)(Args);
static kfn_t kernel_for_kind(int k) {
#if MK_ONE_LAUNCH
    (void)k; return fwd_kernel<0xFFFFFu>;
#else
    switch (k) {
        case 2: return fwd_kernel<1u << 2>; case 4: return fwd_kernel<1u << 4>; case 5: return fwd_kernel<1u << 5>; case 6: return fwd_kernel<1u << 6>;
        case 9: return fwd_kernel<1u << 9>; case 10: return fwd_kernel<1u << 10>; case 12: return fwd_kernel<1u << 12>; case 13: return fwd_kernel<1u << 13>;
        case 14: return fwd_kernel<1u << 14>; case 16: return fwd_kernel<1u << 16>; case 18: return fwd_kernel<1u << 18>;
        default: return fwd_kernel<LIGHT_MASK>;
    }
#endif
}
extern "C" void kernel_launch(void* const* d_in, const int* in_sizes, int n_in, void* d_out, int out_size, void* d_ws, size_t ws_size, hipStream_t stream) {
    static int grid = 0;
    if (grid == 0) {
        if (n_in != 27 || out_size != MTOK * D || ws_size < WS_NEED) { fprintf(stderr, "kernel_launch: unexpected shapes (n_in %d out %d ws %zu, need %zu)\n", n_in, out_size, ws_size, (size_t)WS_NEED); grid = -1; return; }
        int dev = 0, cus = 0;
        if (hipGetDevice(&dev) != hipSuccess || hipDeviceGetAttribute(&cus, hipDeviceAttributeMultiprocessorCount, dev) != hipSuccess) cus = 256;
        for (int k = 0; k < 20; ++k)
            if (hipFuncSetAttribute((const void*)kernel_for_kind(k), hipFuncAttributeMaxDynamicSharedMemorySize, LDS_BYTES) != hipSuccess) { fprintf(stderr, "kernel_launch: hipFuncSetAttribute failed\n"); grid = -1; return; }
        (void)hipGetLastError();
        grid = cus > 0 ? cus : 256;
    }
    if (grid < 0) return;
    Args a{};
    for (int i = 0; i < 27; ++i) a.in[i] = (const float*)d_in[i];
    a.out = (float*)d_out; a.ws = (unsigned char*)d_ws;
#if MK_ONE_LAUNCH
    a.ph_lo = 0; a.ph_hi = N_PHASES;
    if (hipMemsetAsync((char*)d_ws + WS_BAR, 0, XCD_BAR_WORDS * sizeof(unsigned), stream) != hipSuccess) { fprintf(stderr, "kernel_launch: memset of barrier words failed\n"); return; }
    void* args[] = {&a};
    hipError_t e = hipLaunchCooperativeKernel((const void*)fwd_kernel<0xFFFFFu>, dim3(grid), dim3(NTHREADS), args, LDS_BYTES, stream);
    if (e != hipSuccess) fprintf(stderr, "kernel_launch: cooperative launch failed: %s (grid %d)\n", hipGetErrorString(e), grid);
#else
    for (int p = 0; p < N_PHASES; ++p) {
        a.ph_lo = p; a.ph_hi = p + 1;
        hipLaunchKernelGGL(kernel_for_kind(kind_of_phase[p]), dim3(grid), dim3(NTHREADS), LDS_BYTES, stream, a);
    }
#endif
}
```
